# Optimizing an MI355X kernel written in HIP

```python
import jax, jax.numpy as jnp
from jax import lax
import numpy as np

D_MODEL = 1024
BATCH = 32
SEQ = 2048
DEPTH = 4

CHUNK = 64
N_META = 16
Q_BLOCK = 128
PAD = Q_BLOCK - N_META
N_A_LAYERS = DEPTH // 2
N_B_LAYERS = DEPTH - N_A_LAYERS
RMS_EPS = 1e-6
GN_EPS = 1e-5
ROPE_THETA = 10000.0
MASK_VALUE = -1e30

RET_HEADS = 4
RET_QK_DIM = D_MODEL // RET_HEADS
RET_V_DIM = 2 * D_MODEL // RET_HEADS
RET_IN = 2 * RET_HEADS * RET_QK_DIM + 2 * RET_HEADS * RET_V_DIM

MLA_HEADS = 8
MLA_NOPE = 128
MLA_ROPE = 64
MLA_V = 128
MLA_Q_RANK = 768
MLA_KV_RANK = 512

FFN_HIDDEN = ((8 * D_MODEL + 3 * 256 - 1) // (3 * 256)) * 256

kernel_name = "yoco_retention_mla_meta_chunk_causal_trunk"


def rmsnorm(x, g):
    xf = x.astype(jnp.float32)
    y = xf * lax.rsqrt(jnp.mean(xf * xf, axis=-1, keepdims=True) + RMS_EPS)
    return (y * g.astype(jnp.float32)).astype(x.dtype)


def rope_tables(pos, dim):
    inv = 1.0 / (ROPE_THETA ** (jnp.arange(0, dim, 2, dtype=jnp.float32) / dim))
    ang = pos.astype(jnp.float32)[:, None] * inv[None, :]
    return jnp.cos(ang), jnp.sin(ang)


def apply_rope(x, cos, sin):
    xf = x.astype(jnp.float32)
    half = x.shape[-1] // 2
    x1, x2 = xf[..., :half], xf[..., half:]
    c = cos[None, :, None, :]
    s = sin[None, :, None, :]
    return jnp.concatenate([x1 * c - x2 * s, x1 * s + x2 * c], axis=-1).astype(x.dtype)


def retention_mixer(hn, w_in, gn_g, w_o, cos, sin, valid):
    B, L, _ = hn.shape
    H, DK, DV, C = RET_HEADS, RET_QK_DIM, RET_V_DIM, CHUNK
    NC = L // C
    dt = hn.dtype
    proj = hn @ w_in
    q = proj[..., :H * DK].reshape(B, L, H, DK)
    k = proj[..., H * DK:2 * H * DK].reshape(B, L, H, DK)
    v = proj[..., 2 * H * DK:2 * H * DK + H * DV].reshape(B, L, H, DV)
    gate = proj[..., 2 * H * DK + H * DV:]
    q = apply_rope(q, cos, sin)
    k = apply_rope(k, cos, sin) * (DK ** -0.5) * valid[None, :, None, None]

    def to_chunks(t):
        return t.reshape(B, NC, C, H, t.shape[-1]).transpose(1, 0, 3, 2, 4)

    log_g = jnp.log1p(-jnp.exp2(-5.0 - jnp.arange(H, dtype=jnp.float32)))
    idx = jnp.arange(C, dtype=jnp.float32)
    intra = jnp.exp(log_g[:, None, None] * jnp.abs(idx[:, None] - idx[None, :])).astype(dt)
    q_dec = jnp.exp(log_g[:, None] * (idx + 1.0)).astype(dt)
    k_dec = jnp.exp(log_g[:, None] * (C - 1.0 - idx)).astype(dt)
    chunk_dec = jnp.exp(log_g * C).astype(dt)

    def step(S, qkv):
        qc, kc, vc = qkv
        sc = jnp.einsum('bhid,bhjd->bhij', qc, kc) * intra
        o = (jnp.einsum('bhij,bhjv->bhiv', sc, vc)
             + jnp.einsum('bhid,bhdv->bhiv', qc * q_dec[:, :, None], S))
        S = S * chunk_dec[:, None, None] + jnp.einsum('bhjd,bhjv->bhdv', kc * k_dec[:, :, None], vc)
        return S, o

    S0 = jnp.zeros((B, H, DK, DV), dt)
    _, o = lax.scan(step, S0, (to_chunks(q), to_chunks(k), to_chunks(v)))
    o = o.transpose(1, 0, 3, 2, 4).reshape(B, L, H, DV)
    of = o.astype(jnp.float32)
    mu = jnp.mean(of, axis=-1, keepdims=True)
    var = jnp.mean(jnp.square(of - mu), axis=-1, keepdims=True)
    on = ((of - mu) * lax.rsqrt(var + GN_EPS)).reshape(B, L, H * DV) * gn_g.astype(jnp.float32)
    return (jax.nn.silu(gate) * on.astype(dt)) @ w_o


def mla_shared_kv(h, norm_kv_g, w_kv_a, kv_a_norm_g, w_kv_b, cos, sin):
    B, L, _ = h.shape
    kv_a = rmsnorm(h, norm_kv_g) @ w_kv_a
    c_kv = rmsnorm(kv_a[..., :MLA_KV_RANK], kv_a_norm_g)
    k_rope = apply_rope(kv_a[..., MLA_KV_RANK:][:, :, None, :], cos, sin)
    kv = (c_kv @ w_kv_b).reshape(B, L, MLA_HEADS, MLA_NOPE + MLA_V)
    k = jnp.concatenate([kv[..., :MLA_NOPE],
                         jnp.broadcast_to(k_rope, (B, L, MLA_HEADS, MLA_ROPE))], axis=-1)
    return k, kv[..., MLA_NOPE:]


def mla_mixer(hn, w_q_a, q_a_norm_g, w_q_b, w_o, k, v, cos, sin, chunk_id, valid_key):
    B, L, _ = hn.shape
    cq = rmsnorm(hn @ w_q_a, q_a_norm_g)
    q = (cq @ w_q_b).reshape(B, L, MLA_HEADS, MLA_NOPE + MLA_ROPE)
    q = jnp.concatenate([q[..., :MLA_NOPE], apply_rope(q[..., MLA_NOPE:], cos, sin)], axis=-1)
    q = q * ((MLA_NOPE + MLA_ROPE) ** -0.5)
    outs = []
    for qb in range(L // Q_BLOCK):
        s, e = qb * Q_BLOCK, (qb + 1) * Q_BLOCK
        sc = jnp.einsum('bqhd,bkhd->bhqk', q[:, s:e], k[:, :e]).astype(jnp.float32)
        mask = (chunk_id[None, :e] <= chunk_id[s:e, None]) & valid_key[None, :e]
        sc = jnp.where(mask[None, None], sc, MASK_VALUE)
        p = jax.nn.softmax(sc, axis=-1).astype(v.dtype)
        outs.append(jnp.einsum('bhqk,bkhd->bqhd', p, v[:, :e]))
    o = jnp.concatenate(outs, axis=1).reshape(B, L, MLA_HEADS * MLA_V)
    return o @ w_o


def swiglu(hn, w1, w3, w2):
    return (jax.nn.silu(hn @ w1) * (hn @ w3)) @ w2


def setup_inputs(seed: int = 0) -> dict:
    key = jax.random.key(seed)
    ks = jax.random.split(key, 24)
    f32 = jnp.float32
    res = (2 * DEPTH) ** -0.5

    def w(k, shape, fan_in, scale=1.0):
        return jax.random.normal(k, shape, f32) * (fan_in ** -0.5) * scale

    def gain(k, shape):
        return 1.0 + 0.02 * jax.random.normal(k, shape, f32)

    return {
        "x": jax.random.normal(ks[0], (BATCH, SEQ, D_MODEL), f32),
        "meta": jax.random.normal(ks[1], (N_META, D_MODEL), f32),
        "norm_mix_g": gain(ks[2], (DEPTH, D_MODEL)),
        "norm_ffn_g": gain(ks[3], (DEPTH, D_MODEL)),
        "ret_w_in": w(ks[4], (N_A_LAYERS, D_MODEL, RET_IN), D_MODEL),
        "ret_gn_g": gain(ks[5], (N_A_LAYERS, RET_HEADS * RET_V_DIM)),
        "ret_w_o": w(ks[6], (N_A_LAYERS, RET_HEADS * RET_V_DIM, D_MODEL), RET_HEADS * RET_V_DIM, res),
        "mla_norm_kv_g": gain(ks[7], (D_MODEL,)),
        "mla_w_kv_a": w(ks[8], (D_MODEL, MLA_KV_RANK + MLA_ROPE), D_MODEL),
        "mla_kv_a_norm_g": gain(ks[9], (MLA_KV_RANK,)),
        "mla_w_kv_b": w(ks[10], (MLA_KV_RANK, MLA_HEADS * (MLA_NOPE + MLA_V)), MLA_KV_RANK),
        "mla_w_q_a": w(ks[11], (N_B_LAYERS, D_MODEL, MLA_Q_RANK), D_MODEL),
        "mla_q_a_norm_g": gain(ks[12], (N_B_LAYERS, MLA_Q_RANK)),
        "mla_w_q_b": w(ks[13], (N_B_LAYERS, MLA_Q_RANK, MLA_HEADS * (MLA_NOPE + MLA_ROPE)), MLA_Q_RANK),
        "mla_w_o": w(ks[14], (N_B_LAYERS, MLA_HEADS * MLA_V, D_MODEL), MLA_HEADS * MLA_V, res),
        "ffn_w1": w(ks[15], (DEPTH, D_MODEL, FFN_HIDDEN), D_MODEL),
        "ffn_w3": w(ks[16], (DEPTH, D_MODEL, FFN_HIDDEN), D_MODEL),
        "ffn_w2": w(ks[17], (DEPTH, FFN_HIDDEN, D_MODEL), FFN_HIDDEN, res),
        "final_g": gain(ks[18], (D_MODEL,)),
    }


def reference(x, meta, norm_mix_g, norm_ffn_g, ret_w_in, ret_gn_g, ret_w_o,
              mla_norm_kv_g, mla_w_kv_a, mla_kv_a_norm_g, mla_w_kv_b,
              mla_w_q_a, mla_q_a_norm_g, mla_w_q_b, mla_w_o,
              ffn_w1, ffn_w3, ffn_w2, final_g):
    B, S, D = x.shape
    L = PAD + N_META + S
    h = jnp.concatenate([jnp.zeros((B, PAD, D), x.dtype),
                         jnp.broadcast_to(meta[None].astype(x.dtype), (B, N_META, D)),
                         x], axis=1)
    slot = jnp.arange(L)
    chunk_id = slot // CHUNK
    valid_key = slot >= PAD
    valid = valid_key.astype(x.dtype)
    pos = slot - PAD
    cos_r, sin_r = rope_tables(pos, RET_QK_DIM)
    cos_m, sin_m = rope_tables(pos, MLA_ROPE)

    k_sh = None
    v_sh = None
    for layer in range(DEPTH):
        hn = rmsnorm(h, norm_mix_g[layer])
        if layer < N_A_LAYERS:
            h = h + retention_mixer(hn, ret_w_in[layer], ret_gn_g[layer], ret_w_o[layer],
                                    cos_r, sin_r, valid)
        else:
            if layer == N_A_LAYERS:
                k_sh, v_sh = mla_shared_kv(h, mla_norm_kv_g, mla_w_kv_a, mla_kv_a_norm_g,
                                           mla_w_kv_b, cos_m, sin_m)
            j = layer - N_A_LAYERS
            h = h + mla_mixer(hn, mla_w_q_a[j], mla_q_a_norm_g[j], mla_w_q_b[j], mla_w_o[j],
                              k_sh, v_sh, cos_m, sin_m, chunk_id, valid_key)
        h = h + swiglu(rmsnorm(h, norm_ffn_g[layer]), ffn_w1[layer], ffn_w3[layer], ffn_w2[layer])
    return rmsnorm(h, final_g)[:, PAD + N_META:]
```

```cpp
#include <hip/hip_runtime.h>
#include <hip/hip_cooperative_groups.h>
#include <cstdio>
namespace cg = cooperative_groups;

namespace pg8 {
#define PG8_LAS __attribute__((address_space(3)))
typedef unsigned short bf16_t;
typedef short bf16x8 __attribute__((ext_vector_type(8)));
typedef float f32x4 __attribute__((ext_vector_type(4)));
typedef unsigned u32x4 __attribute__((ext_vector_type(4)));
constexpr int BM = 256, BK = 64, HALF = 128, HTB = HALF * BK * 2  , STAGE_BYTES = 8 * HTB, NXCD = 8, WGM = 8;

__host__ __device__ __forceinline__ int lds_byte(int r, int c) { const int st = (r >> 4) * 2 + (c >> 5), rr = r & 15, cc = c & 31, ob = rr * 64 + cc * 2; return st * 1024 + (ob ^ (((ob >> 9) & 1) << 5)); }
__host__ __device__ __forceinline__ void stage_rc(int b, int& R, int& C) { const int st = b / 1024, sb = b % 1024, swz = sb ^ (((sb >> 9) & 1) << 5); R = (st >> 1) * 16 + swz / 64; C = (st & 1) * 32 + (swz % 64) / 2; }
__host__ __device__ __forceinline__ int perm32(int rho) { const int n = rho >> 4, i = rho & 15; return 8 * (i >> 2) + 4 * n + (i & 3); }
struct Unit { int pm, pn; };
struct Gemm { const bf16_t* A; const bf16_t* Bt; int M, N, K, lda; };
struct StaticOrder {
    int nM, nN, nwg, G, c;
    __host__ __device__ void init(int M, int N, int G_, int c_) { nM = M / BM; nN = N / BM; nwg = nM * nN; G = G_; c = c_; }
    __host__ __device__ bool next(int i, Unit& u) const {
        const int L = i * G + c; if (L >= nwg) return false;
        int wgid = L; { const int q = nwg / NXCD, r = nwg % NXCD, xcd = wgid % NXCD, off = wgid / NXCD; wgid = (xcd < r ? xcd * (q + 1) : r * (q + 1) + (xcd - r) * q) + off; }
        const int nig = WGM * nN, gid = wgid / nig, fm = gid * WGM, gsz = (nM - fm) < WGM ? (nM - fm) : WGM;
        u.pm = fm + ((wgid % nig) % gsz); u.pn = (wgid % nig) / gsz; return true;
    }
    __device__ __forceinline__ void a_ready(const Unit&) const {}
    __device__ __forceinline__ void done(const Unit&) const {}
};
template <class Epi, class Sched>
__device__ __forceinline__ void gemm_phase(PG8_LAS unsigned char* lds, const Gemm g, const Sched& S, const Epi& E) {
    int tid_ = threadIdx.x; asm volatile("" : "+v"(tid_));
    const int tid = tid_, wid = __builtin_amdgcn_readfirstlane(tid >> 6), lane = tid & 63, wr = wid >> 2, wc = wid & 3, fr = lane & 15, fq = lane >> 4;
    const int K = g.K, nt = K / BK;
    unsigned voffA[2], voffB[2];
#pragma unroll
    for (int i = 0; i < 2; ++i) { int R, C; stage_rc(tid * 16 + i * 8192, R, C); const int Rb = Epi::PERM ? ((R & ~31) + perm32(R & 31)) : R;
        voffA[i] = (unsigned)(R * g.lda + C) * 2u; voffB[i] = (unsigned)(Rb * K + C) * 2u; }
    const size_t kstep = (size_t)(BK * 2);
    const size_t hstepA = (size_t)HALF * g.lda * 2, hstepB = (size_t)HALF * K * 2;
    const size_t tstepA = 2 * hstepA, tstepB = 2 * hstepB;
    const unsigned ldsw = (unsigned)wid * 1024u;
    const int aoff = lds_byte(wr * 64 + fr, fq * 8), boff = lds_byte(wc * 32 + fr, fq * 8);
#define PG8_SA(b, h) (((b) * 2 + (h)) * HTB)
#define PG8_SB(b, h) ((4 + (b) * 2 + (h)) * HTB)
#define PG8_STAGE(bufoff, gbase, voff) do { _Pragma("unroll") for (int _i = 0; _i < 2; ++_i) \
        __builtin_amdgcn_global_load_lds((const unsigned*)((const char*)(gbase) + (voff)[_i]), (PG8_LAS unsigned*)(lds + (bufoff) + ldsw + _i * 8192), 16, 0, 0); } while (0)
#define PG8_LDA(dst, b, h) do { _Pragma("unroll") for (int m = 0; m < 4; ++m) _Pragma("unroll") for (int k = 0; k < 2; ++k) dst[m][k] = *(const PG8_LAS bf16x8*)(lds + PG8_SA(b, h) + aoff + m * 2048 + k * 1024); } while (0)
#define PG8_LDB(dst, b, h) do { _Pragma("unroll") for (int n = 0; n < 2; ++n) _Pragma("unroll") for (int k = 0; k < 2; ++k) dst[n][k] = *(const PG8_LAS bf16x8*)(lds + PG8_SB(b, h) + boff + n * 2048 + k * 1024); } while (0)
#define PG8_MMA(ai, bj, At, Bt) do { __builtin_amdgcn_s_setprio(1); _Pragma("unroll") for (int m = 0; m < 4; ++m) _Pragma("unroll") for (int n = 0; n < 2; ++n) _Pragma("unroll") for (int k = 0; k < 2; ++k) \
        acc[ai][bj][m][n] = __builtin_amdgcn_mfma_f32_16x16x32_bf16(Bt[n][k], At[m][k], acc[ai][bj][m][n], 0, 0, 0); __builtin_amdgcn_s_setprio(0); } while (0)
#define PG8_WAIT_V(n) asm volatile("s_waitcnt vmcnt(" #n ")" ::: "memory")
#define PG8_WAIT_L(n) asm volatile("s_waitcnt lgkmcnt(" #n ")" ::: "memory")
#define PG8_BAR __builtin_amdgcn_s_barrier()
#define PG8_SCHED __builtin_amdgcn_sched_barrier(0)
    Unit cur, nxt; int ui = 0;
    typename Epi::Pre pre;
    if (!S.next(0, cur)) return;
    f32x4 acc[2][2][4][2];
#pragma unroll
    for (int a = 0; a < 2; ++a)
#pragma unroll
        for (int b = 0; b < 2; ++b)
#pragma unroll
            for (int m = 0; m < 4; ++m)
#pragma unroll
                for (int n = 0; n < 2; ++n) acc[a][b][m][n] = (f32x4){0.f, 0.f, 0.f, 0.f};
    bf16x8 At[4][2], B0[2][2], B1[2][2];
    const char* cA = (const char*)g.A + (size_t)cur.pm * tstepA; const char* cB = (const char*)g.Bt + (size_t)cur.pn * tstepB;
    S.a_ready(cur);
    PG8_STAGE(PG8_SB(0, 0), cB, voffB); PG8_STAGE(PG8_SA(0, 0), cA, voffA); PG8_STAGE(PG8_SB(0, 1), cB + hstepB, voffB); PG8_STAGE(PG8_SA(0, 1), cA + hstepA, voffA);
    if (wr == 1) PG8_BAR;
    PG8_WAIT_V(4); PG8_BAR;
    PG8_STAGE(PG8_SB(1, 0), cB + kstep, voffB); PG8_STAGE(PG8_SA(1, 0), cA + kstep, voffA); PG8_STAGE(PG8_SB(1, 1), cB + hstepB + kstep, voffB);
    PG8_WAIT_V(6); PG8_BAR;
    for (;;) {
        const bool has_next = S.next(ui + 1, nxt);
        const char* nA = has_next ? (const char*)g.A + (size_t)nxt.pm * tstepA : cA; const char* nB = has_next ? (const char*)g.Bt + (size_t)nxt.pn * tstepB : cB;
        for (int t = 0; t < nt; t += 2) {
            const bool last = (t == nt - 2);
            const char* a1 = cA + (size_t)(t + 1) * kstep;
            const char* a2 = last ? nA : cA + (size_t)(t + 2) * kstep; const char* b2 = last ? nB : cB + (size_t)(t + 2) * kstep;
            const char* a3 = a2 + kstep; const char* b3 = b2 + kstep;
            if (last && has_next) S.a_ready(nxt);
            if (last) E.prefetch(pre, cur, wr, fr, fq);
            PG8_LDB(B0, 0, 0); PG8_SCHED; PG8_LDA(At, 0, 0); PG8_STAGE(PG8_SA(1, 1), a1 + hstepA, voffA);
            PG8_WAIT_L(8); PG8_BAR; PG8_WAIT_L(0); PG8_MMA(0, 0, At, B0); PG8_BAR; PG8_SCHED;
            PG8_LDB(B1, 0, 1); PG8_STAGE(PG8_SB(0, 0), b2, voffB);
            PG8_BAR; PG8_WAIT_L(0); PG8_MMA(0, 1, At, B1); PG8_BAR;
            PG8_LDA(At, 0, 1); PG8_STAGE(PG8_SA(0, 0), a2, voffA);
            PG8_BAR; PG8_WAIT_L(0); PG8_MMA(1, 0, At, B0); PG8_BAR; PG8_SCHED;
            PG8_STAGE(PG8_SB(0, 1), b2 + hstepB, voffB);
            PG8_WAIT_V(6); PG8_BAR; PG8_MMA(1, 1, At, B1); PG8_BAR;
            PG8_LDB(B0, 1, 0); PG8_SCHED; PG8_LDA(At, 1, 0); PG8_STAGE(PG8_SA(0, 1), a2 + hstepA, voffA);
            PG8_WAIT_L(8); PG8_BAR; PG8_WAIT_L(0); PG8_MMA(0, 0, At, B0); PG8_BAR; PG8_SCHED;
            PG8_LDB(B1, 1, 1); PG8_STAGE(PG8_SB(1, 0), b3, voffB);
            PG8_BAR; PG8_WAIT_L(0); PG8_MMA(0, 1, At, B1); PG8_BAR;
            PG8_LDA(At, 1, 1); PG8_STAGE(PG8_SA(1, 0), a3, voffA);
            PG8_BAR; PG8_WAIT_L(0); PG8_MMA(1, 0, At, B0); PG8_BAR; PG8_SCHED;
            PG8_STAGE(PG8_SB(1, 1), b3 + hstepB, voffB);
            PG8_WAIT_V(6); PG8_BAR; PG8_MMA(1, 1, At, B1); PG8_BAR;
        }
        if constexpr (!Epi::AFTER_DRAIN) { E(acc, pre, cur, wr, wc, fr, fq); S.done(cur); }
        if (!has_next) break;
#pragma unroll
        for (int a = 0; a < 2; ++a)
#pragma unroll
            for (int b = 0; b < 2; ++b)
#pragma unroll
                for (int m = 0; m < 4; ++m)
#pragma unroll
                    for (int n = 0; n < 2; ++n) acc[a][b][m][n] = (f32x4){0.f, 0.f, 0.f, 0.f};
        cur = nxt; cA = nA; cB = nB; ++ui;
    }
    PG8_WAIT_V(0);
    if (wr == 0) PG8_BAR;
    PG8_BAR;
#undef PG8_SA
#undef PG8_SB
#undef PG8_STAGE
#undef PG8_LDA
#undef PG8_LDB
#undef PG8_MMA
#undef PG8_WAIT_V
#undef PG8_WAIT_L
#undef PG8_BAR
#undef PG8_SCHED
}
}

using pg8::bf16_t; using pg8::bf16x8; using pg8::f32x4; using pg8::u32x4;
typedef float f32x16 __attribute__((ext_vector_type(16)));
typedef float f32x2 __attribute__((ext_vector_type(2)));
typedef short s16x4 __attribute__((ext_vector_type(4)));
typedef unsigned u32x2 __attribute__((ext_vector_type(2)));
typedef __bf16 bf2_t __attribute__((ext_vector_type(2)));
typedef short v4i16_t __attribute__((ext_vector_type(4)));
#define LAS __attribute__((address_space(3)))
#define DI __device__ __forceinline__

constexpr int NB = 32, SEQ = 2048, DM = 1024, LB = 2048  , MR = NB * LB  , NPOS = 2064, FFH = 2816, RIN = 6144;
constexpr float RMS_EPS = 1e-6f, GN_EPS = 1e-5f;
constexpr size_t OFF_PROJ = 0;
constexpr size_t OFF_U = 0, OFF_CQ = 0, OFF_CKV = 103809024ull, OFF_AO = 0, OFF_QN = 173015040ull, OFF_QR = 311427072ull;
constexpr size_t OFF_KN = 380633088ull, OFF_V = 519045120ull, OFF_KR = 657457152ull, OFF_W2 = 666107904ull;
constexpr size_t OFF_HB = 830472192ull, OFF_W1 = 968884224ull, OFF_HM = 1037041664ull, OFF_SSQ = 1045430272ull, OFF_SSQ2 = 1049755648ull, OFF_SSQ3 = 1051918336ull;
constexpr size_t OFF_COSR = 1056243712ull, OFF_SINR = 1057325056ull, OFF_COSM = 1058406400ull, OFF_SINM = 1058676736ull, WS_END = 1058947072ull;
constexpr size_t W1_LAYER = 17039360ull, W1_WO = 6291456ull, W1_WUP = 8388608ull, W1_WDN = 14155776ull;
constexpr size_t W2_KVB = 786432ull, W2_L0 = 1835008ull, W2_LAYER = 11665408ull, W2_WQB = 786432ull, W2_WOM = 1966080ull, W2_WUP = 3014656ull, W2_WDN = 8781824ull;
constexpr int LDS_MA = 0, LDS_MO = 90112, LDS_MRS = 155648;
constexpr int LDS_XB = 155904;
constexpr int LDS_BYTES = LDS_XB + 16;
constexpr size_t OFF_BAR = WS_END, OFF_S0 = WS_END + 16384  , OFF_CM = OFF_S0 + 4194304  , OFF_PM = OFF_CM + 786432, OFF_HMG = OFF_PM + 393216  ,
    OFF_KNM = OFF_HMG + 131072  , OFF_VM = OFF_KNM + 131072, OFF_KRM = OFF_VM + 131072  , OFF_SCG = OFF_KRM + 8192  , WS_END2 = OFF_SCG + 4096;

struct Params {
    const float *x, *meta, *norm_mix_g, *norm_ffn_g, *ret_w_in, *ret_gn_g, *ret_w_o, *mla_norm_kv_g, *mla_w_kv_a, *mla_kv_a_norm_g, *mla_w_kv_b,
        *mla_w_q_a, *mla_q_a_norm_g, *mla_w_q_b, *mla_w_o, *ffn_w1, *ffn_w3, *ffn_w2, *final_g;
    float* out; unsigned char* ws;
};

DI unsigned pk2(float a, float b) { f32x2 v = {a, b}; bf2_t r = __builtin_convertvector(v, bf2_t); return __builtin_bit_cast(unsigned, r); }
DI u32x4 pk8(f32x4 a, f32x4 b) { u32x4 w; w.x = pk2(a[0], a[1]); w.y = pk2(a[2], a[3]); w.z = pk2(b[0], b[1]); w.w = pk2(b[2], b[3]); return w; }
DI float bflo(unsigned w) { return __uint_as_float(w << 16); }
DI float bfhi(unsigned w) { return __uint_as_float(w & 0xffff0000u); }
DI float ex2(float x) { return __builtin_amdgcn_exp2f(x); }
DI float wsum(float v) { v += __shfl_xor(v, 1); v += __shfl_xor(v, 2); v += __shfl_xor(v, 4); v += __shfl_xor(v, 8); v += __shfl_xor(v, 16); v += __shfl_xor(v, 32); return v; }
DI float sum4(const float* p, int n4) { float s = 0.f; for (int i = 0; i < n4; ++i) { const f32x4 a = *(const f32x4*)(p + 4 * i); s += (a[0] + a[1]) + (a[2] + a[3]); } return s; }
DI float silu_f(float a) { return a * __builtin_amdgcn_rcpf(1.0f + ex2(-1.4426950408889634f * a)); }
DI s16x4 vtr(const LAS unsigned char* p) { return __builtin_bit_cast(s16x4, __builtin_amdgcn_ds_read_tr16_b64_v4i16((LAS v4i16_t*)p)); }
DI bf16x8 cat8(s16x4 lo, s16x4 hi) { return __builtin_shufflevector(lo, hi, 0, 1, 2, 3, 4, 5, 6, 7); }
DI bf16x8 cat8u(u32x2 lo, u32x2 hi) { u32x4 w; w.x = lo.x; w.y = lo.y; w.z = hi.x; w.w = hi.y; return __builtin_bit_cast(bf16x8, w); }
#define MFMA32(a, b, c) __builtin_amdgcn_mfma_f32_32x32x16_bf16((a), (b), (c), 0, 0, 0)
#define MFMA16(a, b, c) __builtin_amdgcn_mfma_f32_16x16x32_bf16((a), (b), (c), 0, 0, 0)
template <int S8> DI bf16x8 pack_acc(const f32x16& x) { u32x4 w; w.x = pk2(x[S8 + 0], x[S8 + 1]); w.y = pk2(x[S8 + 2], x[S8 + 3]); w.z = pk2(x[S8 + 4], x[S8 + 5]); w.w = pk2(x[S8 + 6], x[S8 + 7]); return __builtin_bit_cast(bf16x8, w); }

DI const float* hrow_c(const float* frames, const float*, int row) { return frames + ((size_t)row << 10); }
DI float* hrow_m(float* frames, float*, int row) { return frames + ((size_t)row << 10); }

#define EPI_FOR_ROWS _Pragma("unroll") for (int ai = 0; ai < 2; ++ai) _Pragma("unroll") for (int m = 0; m < 4; ++m)
#define EPI_ROW (u.pm * 256 + ai * 128 + wr * 64 + m * 16 + fr)
typedef const f32x4 (&AccRef)[2][2][4][2];
struct PreNone {};
struct PreRstd { float v[8]; };
DI void rstd_load(PreRstd& pre, const float* rs, int row0) {
#pragma unroll
    for (int k = 0; k < 8; ++k) pre.v[k] = rs[row0 + (k >> 2) * 128 + (k & 3) * 16];
}
DI void rstd_reduce(float (&r)[8], const PreRstd& pre, float invn) {
#pragma unroll
    for (int k = 0; k < 8; ++k) r[k] = rsqrtf(pre.v[k] * invn + RMS_EPS);
}
template <int NQ, int STR> DI void rstd_rows(float (&rs)[8], const float* ssq, int row0, int fq, float invn) {
    f32x4 pt[8];
    const int fql = (NQ == 4 || fq < NQ) ? fq : 0; const float keep = (NQ == 4 || fq < NQ) ? 1.0f : 0.0f;
#pragma unroll
    for (int k = 0; k < 8; ++k) { const int row = row0 + (k >> 2) * 128 + (k & 3) * 16; pt[k] = *(const f32x4*)(ssq + (size_t)row * STR + 4 * fql); }
#pragma unroll
    for (int k = 0; k < 8; ++k) { float s = ((pt[k][0] + pt[k][1]) + (pt[k][2] + pt[k][3])) * keep; s += __shfl_xor(s, 16); s += __shfl_xor(s, 32); rs[k] = rsqrtf(s * invn + RMS_EPS); }
}
DI void rope8(u32x4& lo, u32x4& hi, f32x4 x1a, f32x4 x1b, f32x4 x2a, f32x4 x2b, f32x4 c0, f32x4 c1, f32x4 s0, f32x4 s1) {
    lo = pk8(x1a * c0 - x2a * s0, x1b * c1 - x2b * s1); hi = pk8(x1a * s0 + x2a * c0, x1b * s1 + x2b * c1); }

struct EpiWin {
    static constexpr bool PERM = true, AFTER_DRAIN = false; typedef PreRstd Pre;
    bf16_t* P; const float* ssq; const float* cosr; const float* sinr;
    DI void prefetch(Pre& pre, const pg8::Unit& u, int wr, int fr, int fq) const { rstd_load(pre, ssq, u.pm * 256 + wr * 64 + fr); }
    DI void operator()(AccRef acc, const Pre& pre, const pg8::Unit& u, int wr, int wc, int fr, int fq) const {
        asm volatile("" : "+v"(fr), "+v"(fq));
        const int cb = wc * 32 + 8 * fq, row0 = u.pm * 256 + wr * 64 + fr;
        float rs[8]; rstd_reduce(rs, pre, 1.0f / 1024.0f);
        if (u.pn < 8) {
#pragma unroll
            for (int aim = 0; aim < 4; ++aim) { const int ai = aim >> 1, mb = (aim & 1) * 2; f32x4 c0[4], c1[4], s0[4], s1[4];
#pragma unroll
                for (int m = mb; m < mb + 2; ++m) { const int i = (EPI_ROW & 2047) + 16;     const float* cp = cosr + i * 128 + cb; const float* sp = sinr + i * 128 + cb;
                    c0[m] = *(const f32x4*)cp; c1[m] = *(const f32x4*)(cp + 4); s0[m] = *(const f32x4*)sp; s1[m] = *(const f32x4*)(sp + 4); }
#pragma unroll
                for (int m = mb; m < mb + 2; ++m) { const float r = rs[ai * 4 + m]; bf16_t* dst = P + (size_t)EPI_ROW * RIN + u.pn * 256 + cb; u32x4 lo, hi;
                    rope8(lo, hi, acc[ai][0][m][0] * r, acc[ai][0][m][1] * r, acc[ai][1][m][0] * r, acc[ai][1][m][1] * r, c0[m], c1[m], s0[m], s1[m]);
                    *(u32x4*)dst = lo; *(u32x4*)(dst + 128) = hi; } }
        } else {
            EPI_FOR_ROWS { const float r = rs[ai * 4 + m]; bf16_t* dst = P + (size_t)EPI_ROW * RIN + u.pn * 256 + cb;
                *(u32x4*)dst = pk8(acc[ai][0][m][0] * r, acc[ai][0][m][1] * r); *(u32x4*)(dst + 128) = pk8(acc[ai][1][m][0] * r, acc[ai][1][m][1] * r); } }
    }
};
struct EpiRes {
    static constexpr bool PERM = true, AFTER_DRAIN = false; typedef PreNone Pre;
    DI void prefetch(Pre&, const pg8::Unit&, int, int, int) const {}
    const float* src_fr; float* dst_fr; float* hm; bf16_t* HB; float* ssq;
    DI void operator()(AccRef acc, const Pre&, const pg8::Unit& u, int wr, int wc, int fr, int fq) const {
        asm volatile("" : "+v"(fr), "+v"(fq));
        const int cb = u.pn * 256 + wc * 32 + 8 * fq;
#pragma unroll
        for (int ai = 0; ai < 2; ++ai) { f32x4 hv[4][4];
#pragma unroll
            for (int m = 0; m < 4; ++m) { const float* s = hrow_c(src_fr, hm, EPI_ROW) + cb; hv[m][0] = *(const f32x4*)s; hv[m][1] = *(const f32x4*)(s + 4); hv[m][2] = *(const f32x4*)(s + 128); hv[m][3] = *(const f32x4*)(s + 132); }
#pragma unroll
            for (int m = 0; m < 4; ++m) { const int row = EPI_ROW; float* d = hrow_m(dst_fr, hm, row) + cb; float ss = 0.f;
#pragma unroll
                for (int bj = 0; bj < 2; ++bj) { const f32x4 h0 = hv[m][2 * bj] + acc[ai][bj][m][0], h1 = hv[m][2 * bj + 1] + acc[ai][bj][m][1];
                    *(f32x4*)(d + bj * 128) = h0; *(f32x4*)(d + bj * 128 + 4) = h1; *(u32x4*)(HB + (size_t)row * DM + cb + bj * 128) = pk8(h0, h1);
                    ss += (h0[0] * h0[0] + h0[1] * h0[1]) + (h0[2] * h0[2] + h0[3] * h0[3]) + (h1[0] * h1[0] + h1[1] * h1[1]) + (h1[2] * h1[2] + h1[3] * h1[3]); }
                ss += __shfl_xor(ss, 16); ss += __shfl_xor(ss, 32);
                if (fq == 0) unsafeAtomicAdd(ssq + row, ss); } }
    }
};
struct EpiUp {
    static constexpr bool PERM = true, AFTER_DRAIN = false; typedef PreRstd Pre;
    bf16_t* U; const float* ssq;
    DI void prefetch(Pre& pre, const pg8::Unit& u, int wr, int fr, int fq) const { rstd_load(pre, ssq, u.pm * 256 + wr * 64 + fr); }
    DI void operator()(AccRef acc, const Pre& pre, const pg8::Unit& u, int wr, int wc, int fr, int fq) const {
        asm volatile("" : "+v"(fr), "+v"(fq));
        const int cb = u.pn * 128 + wc * 32 + 8 * fq, row0 = u.pm * 256 + wr * 64 + fr;
        float rs[8]; rstd_reduce(rs, pre, 1.0f / 1024.0f);
        EPI_FOR_ROWS { const float r = rs[ai * 4 + m], k1 = -1.4426950408889634f * r, rr = r * r; f32x4 o0, o1;
            const f32x4 p0 = acc[ai][0][m][0] * acc[ai][1][m][0] * rr, p1 = acc[ai][0][m][1] * acc[ai][1][m][1] * rr, m0 = acc[ai][0][m][0] * k1, m1 = acc[ai][0][m][1] * k1;
#pragma unroll
            for (int e = 0; e < 4; ++e) { o0[e] = p0[e] * __builtin_amdgcn_rcpf(1.0f + ex2(m0[e])); o1[e] = p1[e] * __builtin_amdgcn_rcpf(1.0f + ex2(m1[e])); }
            *(u32x4*)(U + (size_t)EPI_ROW * FFH + cb) = pk8(o0, o1); }
    }
};
struct EpiKva {
    static constexpr bool PERM = true, AFTER_DRAIN = false; typedef PreRstd Pre;
    bf16_t* CKV; bf16_t* Kr; const float* ssq; float* ssq2; const float* cosm; const float* sinm;
    DI void prefetch(Pre& pre, const pg8::Unit& u, int wr, int fr, int fq) const { rstd_load(pre, ssq, u.pm * 256 + wr * 64 + fr); }
    DI void operator()(AccRef acc, const Pre& pre, const pg8::Unit& u, int wr, int wc, int fr, int fq) const {
        asm volatile("" : "+v"(fr), "+v"(fq));
        const int row0 = u.pm * 256 + wr * 64 + fr;
        float rs[8]; rstd_reduce(rs, pre, 1.0f / 1024.0f);
        if (u.pn < 2) {
            EPI_FOR_ROWS { const int row = EPI_ROW; const float r = rs[ai * 4 + m];
                const f32x4 x1a = acc[ai][0][m][0] * r, x1b = acc[ai][0][m][1] * r, x2a = acc[ai][1][m][0] * r, x2b = acc[ai][1][m][1] * r;
                bf16_t* dst = CKV + (size_t)row * 512 + u.pn * 256 + wc * 32 + 8 * fq; *(u32x4*)dst = pk8(x1a, x1b); *(u32x4*)(dst + 128) = pk8(x2a, x2b);
                float ss = 0.f;
#pragma unroll
                for (int e = 0; e < 4; ++e) ss += x1a[e] * x1a[e] + x1b[e] * x1b[e] + x2a[e] * x2a[e] + x2b[e] * x2b[e];
                ss += __shfl_xor(ss, 16); ss += __shfl_xor(ss, 32);
                if (fq == 0) ssq2[(size_t)row * 8 + u.pn * 4 + wc] = ss; }
        } else if (wc == 0) { const int f0 = 8 * fq;
#pragma unroll
            for (int aim = 0; aim < 4; ++aim) { const int ai = aim >> 1, mb = (aim & 1) * 2; f32x4 c0[4], c1[4], s0[4], s1[4];
#pragma unroll
                for (int m = mb; m < mb + 2; ++m) { const int i = (EPI_ROW & 2047) + 16;     const float* cp = cosm + i * 32 + f0; const float* sp = sinm + i * 32 + f0;
                    c0[m] = *(const f32x4*)cp; c1[m] = *(const f32x4*)(cp + 4); s0[m] = *(const f32x4*)sp; s1[m] = *(const f32x4*)(sp + 4); }
#pragma unroll
                for (int m = mb; m < mb + 2; ++m) { const float r = rs[ai * 4 + m]; bf16_t* dst = Kr + (size_t)EPI_ROW * 64 + f0; u32x4 lo, hi;
                    rope8(lo, hi, acc[ai][0][m][0] * r, acc[ai][0][m][1] * r, acc[ai][1][m][0] * r, acc[ai][1][m][1] * r, c0[m], c1[m], s0[m], s1[m]);
                    *(u32x4*)dst = lo; *(u32x4*)(dst + 32) = hi; } } }
    }
};
struct EpiKvb {
    static constexpr bool PERM = true, AFTER_DRAIN = false; typedef PreNone Pre;
    bf16_t* Kn; bf16_t* V; const float* ssq2;
    DI void prefetch(Pre&, const pg8::Unit&, int, int, int) const {}
    DI void operator()(AccRef acc, const Pre&, const pg8::Unit& u, int wr, int wc, int fr, int fq) const {
        asm volatile("" : "+v"(fr), "+v"(fq));
        const int cb = u.pn * 128 + wc * 32 + 8 * fq, row0 = u.pm * 256 + wr * 64 + fr;
        float rs[8]; rstd_rows<2, 8>(rs, ssq2, row0, fq, 1.0f / 512.0f);
        EPI_FOR_ROWS { const int row = EPI_ROW; const float r = rs[ai * 4 + m];
            *(u32x4*)(Kn + (size_t)row * DM + cb) = pk8(acc[ai][0][m][0] * r, acc[ai][0][m][1] * r); *(u32x4*)(V + (size_t)row * DM + cb) = pk8(acc[ai][1][m][0] * r, acc[ai][1][m][1] * r); }
    }
};
struct EpiQa {
    static constexpr bool PERM = true, AFTER_DRAIN = false; typedef PreRstd Pre;
    bf16_t* CQ; const float* ssq; float* ssq3;
    DI void prefetch(Pre& pre, const pg8::Unit& u, int wr, int fr, int fq) const { rstd_load(pre, ssq, u.pm * 256 + wr * 64 + fr); }
    DI void operator()(AccRef acc, const Pre& pre, const pg8::Unit& u, int wr, int wc, int fr, int fq) const {
        asm volatile("" : "+v"(fr), "+v"(fq));
        const int row0 = u.pm * 256 + wr * 64 + fr;
        float rs[8]; rstd_reduce(rs, pre, 1.0f / 1024.0f);
        EPI_FOR_ROWS { const int row = EPI_ROW; const float r = rs[ai * 4 + m];
            const f32x4 x1a = acc[ai][0][m][0] * r, x1b = acc[ai][0][m][1] * r, x2a = acc[ai][1][m][0] * r, x2b = acc[ai][1][m][1] * r;
            bf16_t* dst = CQ + (size_t)row * 768 + u.pn * 256 + wc * 32 + 8 * fq; *(u32x4*)dst = pk8(x1a, x1b); *(u32x4*)(dst + 128) = pk8(x2a, x2b);
            float ss = 0.f;
#pragma unroll
            for (int e = 0; e < 4; ++e) ss += x1a[e] * x1a[e] + x1b[e] * x1b[e] + x2a[e] * x2a[e] + x2b[e] * x2b[e];
            ss += __shfl_xor(ss, 16); ss += __shfl_xor(ss, 32);
            if (fq == 0) ssq3[(size_t)row * 16 + u.pn * 4 + wc] = ss; }
    }
};
struct EpiQb {
    static constexpr bool PERM = true, AFTER_DRAIN = false; typedef PreNone Pre;
    bf16_t* Qn; bf16_t* Qr; const float* ssq3; const float* cosm; const float* sinm;
    DI void prefetch(Pre&, const pg8::Unit&, int, int, int) const {}
    DI void operator()(AccRef acc, const Pre&, const pg8::Unit& u, int wr, int wc, int fr, int fq) const {
        asm volatile("" : "+v"(fr), "+v"(fq));
        const int row0 = u.pm * 256 + wr * 64 + fr;
        float rs[8]; rstd_rows<3, 16>(rs, ssq3, row0, fq, 1.0f / 768.0f);
        if (u.pn < 4) {
            EPI_FOR_ROWS { const float r = rs[ai * 4 + m]; bf16_t* dst = Qn + (size_t)EPI_ROW * DM + u.pn * 256 + wc * 32 + 8 * fq;
                *(u32x4*)dst = pk8(acc[ai][0][m][0] * r, acc[ai][0][m][1] * r); *(u32x4*)(dst + 128) = pk8(acc[ai][1][m][0] * r, acc[ai][1][m][1] * r); }
        } else { const int f0 = 8 * fq, head = 4 * (u.pn - 4) + wc;
#pragma unroll
            for (int aim = 0; aim < 4; ++aim) { const int ai = aim >> 1, mb = (aim & 1) * 2; f32x4 c0[4], c1[4], s0[4], s1[4];
#pragma unroll
                for (int m = mb; m < mb + 2; ++m) { const int i = (EPI_ROW & 2047) + 16;     const float* cp = cosm + i * 32 + f0; const float* sp = sinm + i * 32 + f0;
                    c0[m] = *(const f32x4*)cp; c1[m] = *(const f32x4*)(cp + 4); s0[m] = *(const f32x4*)sp; s1[m] = *(const f32x4*)(sp + 4); }
#pragma unroll
                for (int m = mb; m < mb + 2; ++m) { const float r = rs[ai * 4 + m]; bf16_t* dst = Qr + (size_t)EPI_ROW * 512 + head * 64 + f0; u32x4 lo, hi;
                    rope8(lo, hi, acc[ai][0][m][0] * r, acc[ai][0][m][1] * r, acc[ai][1][m][0] * r, acc[ai][1][m][1] * r, c0[m], c1[m], s0[m], s1[m]);
                    *(u32x4*)dst = lo; *(u32x4*)(dst + 32) = hi; } } }
    }
};
struct EpiNull { static constexpr bool PERM = true, AFTER_DRAIN = false; typedef PreNone Pre;
    DI void prefetch(Pre&, const pg8::Unit&, int, int, int) const {} float* sink;
    DI void operator()(AccRef acc, const Pre&, const pg8::Unit& u, int wr, int wc, int fr, int fq) const { float s = 0.f;
        EPI_FOR_ROWS { s += acc[ai][0][m][0][0] + acc[ai][1][m][1][3] + acc[ai][0][m][1][2] + acc[ai][1][m][0][1]; }
        if (s == 123.456f) sink[0] = s; } };
template <class Epi> DI void run_gemm(LAS unsigned char* lds, const bf16_t* A, int lda, const bf16_t* Bt, int N, int K, const Epi& E) {
    pg8::Gemm g{A, Bt, MR, N, K, lda}; pg8::StaticOrder S; S.init(MR, N, (int)gridDim.x, (int)blockIdx.x);
    pg8::gemm_phase<Epi, pg8::StaticOrder>(lds, g, S, E);
}

DI int wmap(int type, int n, int& which, float& nscale) {
    which = 0; nscale = 1.0f;
    if (type == 0) return n;
    if (type == 1) { if (n >= 1024 && n < 2048) nscale = 0.0625f; return n; }
    if (type == 2) { const int g = n >> 8, s = (n >> 7) & 1, j = n & 127; which = s; return g * 128 + j; }
    if (type == 3) { if (n < 512) return n; const int c = n - 512; if (c < 32) return 512 + c; if (c >= 128 && c < 160) return 544 + (c - 128); return -1; }
      { if (n < 1024) { const int head = n >> 7, dim = n & 127; return head * 192 + dim; }
        const int c0 = n - 1024, tt = c0 >> 8, c = c0 & 255, half = c >> 7, c1 = c & 127, hh = c1 >> 5, i = c1 & 31, head = 4 * tt + hh; return head * 192 + 128 + 32 * half + i; }
}
DI int otid() { int t = threadIdx.x; asm volatile("" : "+v"(t)); return t; }
DI void convert_job(const float* jsrc, const float* jsrc2, const float* jgain, bf16_t* jdst, const int jK, const int jNsrc, const int jN, const int jtype, const float jscale, LAS unsigned char* lds, const int first, const int stride) {
    const int tid = otid(), nTk = jK >> 6, ntiles = (jN >> 6) * nTk;
    LAS bf16_t* T = (LAS bf16_t*)lds;
    for (int tile = first; tile < ntiles; tile += stride) {
        const int tn = tile / nTk, tk = tile - tn * nTk, n0 = tn * 64, k0 = tk * 64;
        { const int kl = tid >> 3, n8 = (tid & 7) * 8; int which; float ns; const int sc = wmap(jtype, n0 + n8, which, ns);
          f32x4 a = {0.f, 0.f, 0.f, 0.f}, b = a;
          if (sc >= 0) { const float* s = (which ? jsrc2 : jsrc) + (size_t)(k0 + kl) * jNsrc + sc; a = *(const f32x4*)s; b = *(const f32x4*)(s + 4);
              const float f = (jgain ? jgain[k0 + kl] : 1.0f) * jscale * ns; a *= f; b *= f; }
          const unsigned w0 = pk2(a[0], a[1]), w1 = pk2(a[2], a[3]), w2 = pk2(b[0], b[1]), w3 = pk2(b[2], b[3]);
          T[(n8 + 0) * 72 + kl] = (bf16_t)(w0 & 0xffffu); T[(n8 + 1) * 72 + kl] = (bf16_t)(w0 >> 16); T[(n8 + 2) * 72 + kl] = (bf16_t)(w1 & 0xffffu); T[(n8 + 3) * 72 + kl] = (bf16_t)(w1 >> 16);
          T[(n8 + 4) * 72 + kl] = (bf16_t)(w2 & 0xffffu); T[(n8 + 5) * 72 + kl] = (bf16_t)(w2 >> 16); T[(n8 + 6) * 72 + kl] = (bf16_t)(w3 & 0xffffu); T[(n8 + 7) * 72 + kl] = (bf16_t)(w3 >> 16); }
        __syncthreads();
        { const int nl = tid >> 3, k8 = (tid & 7) * 8; const u32x4 v = *(const LAS u32x4*)(T + nl * 72 + k8); *(u32x4*)(jdst + (size_t)(n0 + nl) * jK + k0 + k8) = v; }
        __syncthreads();
    }
}
DI void convert_set1(const Params& p, LAS unsigned char* lds) {
    bf16_t* W1 = (bf16_t*)(p.ws + OFF_W1);
    for (int l = 0; l < 2; ++l) { bf16_t* wl = W1 + l * W1_LAYER;
        convert_job(p.ret_w_in + (size_t)l * 1024 * 6144, nullptr, p.norm_mix_g + l * 1024, wl, 1024, 6144, 6144, 1, 1.0f, lds, (int)blockIdx.x, (int)gridDim.x);
        convert_job(p.ret_w_o + (size_t)l * 2048 * 1024, nullptr, nullptr, wl + W1_WO, 2048, 1024, 1024, 0, 1.0f, lds, (int)blockIdx.x, (int)gridDim.x);
        convert_job(p.ffn_w1 + (size_t)l * 1024 * FFH, p.ffn_w3 + (size_t)l * 1024 * FFH, p.norm_ffn_g + l * 1024, wl + W1_WUP, 1024, FFH, 5632, 2, 1.0f, lds, (int)blockIdx.x, (int)gridDim.x);
        convert_job(p.ffn_w2 + (size_t)l * FFH * 1024, nullptr, nullptr, wl + W1_WDN, FFH, 1024, 1024, 0, 1.0f, lds, (int)blockIdx.x, (int)gridDim.x); }
}
DI void convert_set2(const Params& p, LAS unsigned char* lds, const int first, const int stride) {
    bf16_t* W2 = (bf16_t*)(p.ws + OFF_W2);
    convert_job(p.mla_w_kv_a, nullptr, p.mla_norm_kv_g, W2, 1024, 576, 768, 3, 1.0f, lds, first, stride);
    convert_job(p.mla_w_kv_b, nullptr, p.mla_kv_a_norm_g, W2 + W2_KVB, 512, 2048, 2048, 0, 1.0f, lds, first, stride);
    for (int jj = 0; jj < 2; ++jj) { bf16_t* wl = W2 + W2_L0 + jj * W2_LAYER; const int l = 2 + jj;
        convert_job(p.mla_w_q_a + (size_t)jj * 1024 * 768, nullptr, p.norm_mix_g + l * 1024, wl, 1024, 768, 768, 0, 1.0f, lds, first, stride);
        convert_job(p.mla_w_q_b + (size_t)jj * 768 * 1536, nullptr, p.mla_q_a_norm_g + jj * 768, wl + W2_WQB, 768, 1536, 1536, 4, 0.07216878364870322f * 1.4426950408889634f, lds, first, stride);
        convert_job(p.mla_w_o + (size_t)jj * 1024 * 1024, nullptr, nullptr, wl + W2_WOM, 1024, 1024, 1024, 0, 1.0f, lds, first, stride);
        convert_job(p.ffn_w1 + (size_t)l * 1024 * FFH, p.ffn_w3 + (size_t)l * 1024 * FFH, p.norm_ffn_g + l * 1024, wl + W2_WUP, 1024, FFH, 5632, 2, 1.0f, lds, first, stride);
        convert_job(p.ffn_w2 + (size_t)l * FFH * 1024, nullptr, nullptr, wl + W2_WDN, FFH, 1024, 1024, 0, 1.0f, lds, first, stride); }
}

DI void prologue_rows(const Params& p) {
    const int tid = otid(), lane = tid & 63, gw = blockIdx.x * 8 + (tid >> 6), nw = gridDim.x * 8;
    bf16_t* HB = (bf16_t*)(p.ws + OFF_HB); float* SSQ = (float*)(p.ws + OFF_SSQ);
    for (int row0 = gw; row0 < MR; row0 += 2 * nw) {
        f32x4 v[2][4]; int rows[2];
#pragma unroll
        for (int u = 0; u < 2; ++u) { const int rw = row0 + u * nw, row = rw < MR ? rw : row0; rows[u] = row; const float* src = p.x + ((size_t)row << 10);
#pragma unroll
            for (int c = 0; c < 4; ++c) v[u][c] = *(const f32x4*)(src + c * 256 + lane * 4); }
#pragma unroll
        for (int u = 0; u < 2; ++u) { if (u == 1 && row0 + nw >= MR) break; const int row = rows[u]; float ss = 0.f;
#pragma unroll
            for (int c = 0; c < 4; ++c) { const int col = c * 256 + lane * 4; const f32x4 w4 = v[u][c];
                ss += (w4[0] * w4[0] + w4[1] * w4[1]) + (w4[2] * w4[2] + w4[3] * w4[3]);
                u32x2 w; w.x = pk2(w4[0], w4[1]); w.y = pk2(w4[2], w4[3]); *(u32x2*)(HB + (size_t)row * DM + col) = w; }
            ss = wsum(ss);
            if (lane == 0) { SSQ[row] = ss; SSQ[MR + row] = 0.f; } } }
    const int gt = blockIdx.x * 512 + tid, nt = gridDim.x * 512;
    float* cosr = (float*)(p.ws + OFF_COSR); float* sinr = (float*)(p.ws + OFF_SINR); float* cosm = (float*)(p.ws + OFF_COSM); float* sinm = (float*)(p.ws + OFF_SINM);
    for (int idx = gt; idx < NPOS * 160; idx += nt) { const int i = idx / 160, f = idx - i * 160; const bool isr = f < 128; const int ff = isr ? f : f - 128;
        const float inv = 1.0f / exp2f((isr ? (float)ff * (1.0f / 128.0f) : (float)ff * (1.0f / 32.0f)) * 13.287712379549449f);
        const float ang = (float)i * inv; const double rev = (double)ang * 0.15915494309189535; const float fr = (float)(rev - __builtin_rint(rev));
        const float c = __builtin_amdgcn_cosf(fr), s = __builtin_amdgcn_sinf(fr);
        if (isr) { cosr[i * 128 + ff] = c; sinr[i * 128 + ff] = s; } else { cosm[i * 32 + ff] = c; sinm[i * 32 + ff] = s; } }
}

template <bool DUMMY> DI void ret_phase(LAS unsigned char* lds, bf16_t* PROJ, bf16_t* HBD, const float* S0l) {
    constexpr int QS = 528, KS = 576, SS = 144, OQ = 0, OK = 33792, OV = OK + 36864, OS = OV + 36864;
    const int tid = otid(), wave = tid >> 6, lane = tid & 63, r = lane & 31, h = lane >> 5, fr = lane & 15, fq = lane >> 4, g1 = (lane >> 4) & 1, q4 = (lane & 15) >> 2, p4 = lane & 3;
    for (int item = blockIdx.x; item < 256; item += gridDim.x) {
        const int b = item >> 3, hd = (item >> 1) & 3, half = item & 1;
        const float lg2 = log2f(1.0f - exp2f(-5.0f - (float)hd)), cdec = ex2(lg2 * 64.0f);
        const int cw = wave * 32;
        f32x16 S[8];
        int ls_ = lane; asm volatile("" : "+v"(ls_)); const float* s0p = S0l + (size_t)(hd * 256 + 4 * (ls_ >> 5)) * 512 + half * 256 + cw + (ls_ & 31);
#pragma unroll
        for (int t = 0; t < 8; ++t)
#pragma unroll
            for (int e = 0; e < 16; ++e) S[t][e] = s0p[(32 * t + (e & 3) + 8 * (e >> 2)) * 512];
        for (int c = 0; c < 32; ++c) {
            float lg = lg2; int lc_ = lane; asm volatile("" : "+v"(lg), "+v"(lc_));
            const int r = lc_ & 31, h = lc_ >> 5, fr = lc_ & 15, fq = lc_ >> 4, g1 = (lc_ >> 4) & 1, q4 = (lc_ & 15) >> 2, p4 = lc_ & 3;
            bf16_t* base = PROJ + ((size_t)b * LB + c * 64) * RIN;
            int toff = (tid >> 5) * RIN + (tid & 31) * 8, ooff = (lane >> 2) * RIN + 2048 + hd * 512 + half * 256 + cw + (lane & 3) * 8; asm volatile("" : "+v"(toff), "+v"(ooff));
#pragma unroll
            for (int i = 0; i < 4; ++i) { const int row = (tid >> 5) + 16 * i, seg = tid & 31; const bf16_t* s = base + toff + i * 16 * RIN;
                const u32x4 vq = *(const u32x4*)(s + hd * 256), vk = *(const u32x4*)(s + 1024 + hd * 256), vv = *(const u32x4*)(s + 2048 + hd * 512 + half * 256);
                *(LAS u32x4*)(lds + OQ + row * QS + seg * 16) = vq; *(LAS u32x4*)(lds + OK + row * KS + seg * 16) = vk; *(LAS u32x4*)(lds + OV + row * KS + seg * 16) = vv; }
            __syncthreads();
#pragma unroll
            for (int t2 = 0; t2 < 2; ++t2) { const int tt = wave * 2 + t2, i0 = (tt >> 2) * 16, j0 = (tt & 3) * 16; f32x4 a4 = {0.f, 0.f, 0.f, 0.f};
#pragma unroll
                for (int ks = 0; ks < 8; ++ks) { const bf16x8 ka = *(const LAS bf16x8*)(lds + OK + (j0 + fr) * KS + (32 * ks + 8 * fq) * 2), qb = *(const LAS bf16x8*)(lds + OQ + (i0 + fr) * QS + (32 * ks + 8 * fq) * 2);
                    a4 = MFMA16(ka, qb, a4); }
                const int ii = i0 + fr, jb = j0 + 4 * fq;
                float frq = (float)(fr - 4 * fq); asm volatile("" : "+v"(frq));
#pragma unroll
                for (int e = 0; e < 4; ++e) a4[e] *= ex2(lg * fabsf(frq + (float)(i0 - j0 - e)));
                u32x2 w; w.x = pk2(a4[0], a4[1]); w.y = pk2(a4[2], a4[3]); *(LAS u32x2*)(lds + OS + ii * SS + jb * 2) = w; }
            __syncthreads();
            bf16x8 vB[4];
#pragma unroll
            for (int ks = 0; ks < 4; ++ks) { const LAS unsigned char* a = lds + OV + (16 * ks + 8 * h + q4) * KS + (cw + 16 * g1 + 4 * p4) * 2; vB[ks] = cat8(vtr(a), vtr(a + 4 * KS)); }
            f32x16 o0, o1;
#pragma unroll
            for (int e = 0; e < 16; ++e) { o0[e] = 0.f; o1[e] = 0.f; }
#pragma unroll
            for (int t = 0; t < 8; ++t) {
                { const bf16x8 sb = pack_acc<0>(S[t]); const LAS unsigned char* qa = lds + OQ + r * QS + (32 * t + 4 * h) * 2;
                  const bf16x8 A0 = cat8u(*(const LAS u32x2*)qa, *(const LAS u32x2*)(qa + 16)), A1 = cat8u(*(const LAS u32x2*)(qa + 32 * QS), *(const LAS u32x2*)(qa + 32 * QS + 16));
                  o0 = MFMA32(A0, sb, o0); o1 = MFMA32(A1, sb, o1); }
                { const bf16x8 sb = pack_acc<8>(S[t]); const LAS unsigned char* qa = lds + OQ + r * QS + (32 * t + 16 + 4 * h) * 2;
                  const bf16x8 A0 = cat8u(*(const LAS u32x2*)qa, *(const LAS u32x2*)(qa + 16)), A1 = cat8u(*(const LAS u32x2*)(qa + 32 * QS), *(const LAS u32x2*)(qa + 32 * QS + 16));
                  o0 = MFMA32(A0, sb, o0); o1 = MFMA32(A1, sb, o1); }
                }
#pragma unroll
            for (int e = 0; e < 16; ++e) { float hf4 = (float)(4 * h); asm volatile("" : "+v"(hf4)); const float tk = hf4 + (float)((e & 3) + 8 * (e >> 2) + 1); o0[e] *= ex2(lg * tk); o1[e] *= ex2(lg * (tk + 32.f)); }
#pragma unroll
            for (int ks = 0; ks < 4; ++ks) { const LAS unsigned char* sa = lds + OS + r * SS + (16 * ks + 8 * h) * 2;
                o0 = MFMA32(*(const LAS bf16x8*)sa, vB[ks], o0); o1 = MFMA32(*(const LAS bf16x8*)(sa + 32 * SS), vB[ks], o1); }
            { LAS bf16_t* vs = (LAS bf16_t*)(lds + OV) + cw + r;
#pragma unroll
              for (int e = 0; e < 16; ++e) { const int tk = (e & 3) + 8 * (e >> 2) + 4 * h; vs[tk * (KS / 2)] = (bf16_t)(pk2(o0[e], 0.f) & 0xffffu); vs[(tk + 32) * (KS / 2)] = (bf16_t)(pk2(o1[e], 0.f) & 0xffffu); }
              bf16_t* od = base + ooff;
              const LAS unsigned char* os = lds + OV + (lane >> 2) * KS + (cw + (lane & 3) * 8) * 2;
#pragma unroll
              for (int ps = 0; ps < 4; ++ps) { const u32x4 v = *(const LAS u32x4*)(os + ps * 16 * KS);
                  if (DUMMY) *(u32x4*)(HBD + ((size_t)b * LB + c * 64 + (lane >> 2) + 16 * ps) * DM + ((hd * 512 + half * 256 + cw + (lane & 3) * 8) & 1023)) = v;
                  else *(u32x4*)(od + (size_t)ps * 16 * RIN) = v; } }
            __builtin_amdgcn_sched_barrier(0);
#pragma unroll
            for (int ks = 0; ks < 4; ++ks) { float hf4 = (float)(4 * h); asm volatile("" : "+v"(hf4)); u32x4 w = __builtin_bit_cast(u32x4, vB[ks]); const float t0 = (float)(63 - 16 * ks) - 2.0f * hf4;
                u32x4 o; o.x = pk2(bflo(w.x) * ex2(lg * t0), bfhi(w.x) * ex2(lg * (t0 - 1.f))); o.y = pk2(bflo(w.y) * ex2(lg * (t0 - 2.f)), bfhi(w.y) * ex2(lg * (t0 - 3.f)));
                o.z = pk2(bflo(w.z) * ex2(lg * (t0 - 4.f)), bfhi(w.z) * ex2(lg * (t0 - 5.f))); o.w = pk2(bflo(w.w) * ex2(lg * (t0 - 6.f)), bfhi(w.w) * ex2(lg * (t0 - 7.f)));
                vB[ks] = __builtin_bit_cast(bf16x8, o); }
            __builtin_amdgcn_sched_barrier(0);
#pragma unroll
            for (int t = 0; t < 8; ++t) { S[t] *= cdec;
#pragma unroll
                for (int ks = 0; ks < 4; ++ks) { const LAS unsigned char* a = lds + OK + (16 * ks + 8 * h + q4) * KS + (32 * t + 16 * g1 + 4 * p4) * 2;
                    S[t] = MFMA32(cat8(vtr(a), vtr(a + 4 * KS)), vB[ks], S[t]); }
                }
            __syncthreads();
        }
    }
}
DI void gn_phase(const Params& p, int layer, bf16_t* PROJ) {
    const int tid = otid(), lane = tid & 63, gw = blockIdx.x * 8 + (tid >> 6), nw = gridDim.x * 8;
    const float* gg = p.ret_gn_g + layer * 2048;
    for (int row0 = gw; row0 < MR; row0 += 2 * nw) {
        u32x4 vo4[2][4], vg4[2][4]; bf16_t* prs[2];
#pragma unroll
        for (int u = 0; u < 2; ++u) { const int rw = row0 + u * nw, row = rw < MR ? rw : row0; prs[u] = PROJ + (size_t)row * RIN + 2048 + lane * 8;
#pragma unroll
            for (int hd = 0; hd < 4; ++hd) { vo4[u][hd] = *(const u32x4*)(prs[u] + hd * 512); vg4[u][hd] = *(const u32x4*)(prs[u] + 2048 + hd * 512); } }
#pragma unroll
        for (int u = 0; u < 2; ++u) { if (u == 1 && row0 + nw >= MR) break; bf16_t* pr = prs[u];
#pragma unroll
            for (int hd = 0; hd < 4; ++hd) { const u32x4 vo = vo4[u][hd], vg = vg4[u][hd];
                float o[8] = {bflo(vo.x), bfhi(vo.x), bflo(vo.y), bfhi(vo.y), bflo(vo.z), bfhi(vo.z), bflo(vo.w), bfhi(vo.w)};
                float g[8] = {bflo(vg.x), bfhi(vg.x), bflo(vg.y), bfhi(vg.y), bflo(vg.z), bfhi(vg.z), bflo(vg.w), bfhi(vg.w)};
                float s = 0.f;
#pragma unroll
                for (int e = 0; e < 8; ++e) s += o[e];
                const float mu = wsum(s) * (1.0f / 512.0f); float q = 0.f;
#pragma unroll
                for (int e = 0; e < 8; ++e) { o[e] -= mu; q += o[e] * o[e]; }
                const float rstd = rsqrtf(wsum(q) * (1.0f / 512.0f) + GN_EPS);
                const f32x4 ga = *(const f32x4*)(gg + hd * 512 + lane * 8), gb = *(const f32x4*)(gg + hd * 512 + lane * 8 + 4);
                f32x4 ra, rb;
#pragma unroll
                for (int e = 0; e < 4; ++e) { ra[e] = silu_f(g[e]) * (o[e] * rstd * ga[e]); rb[e] = silu_f(g[4 + e]) * (o[4 + e] * rstd * gb[e]); }
                *(u32x4*)(pr + 2048 + hd * 512) = pk8(ra, rb); } } }
}

DI void attn_phase(LAS unsigned char* lds, const bf16_t* Qn, const bf16_t* Qr, const bf16_t* Kn, const bf16_t* Kr, const bf16_t* V, bf16_t* AO, const bf16_t* KnM, const bf16_t* KrM, const bf16_t* VM) {
    constexpr int KST = 400, VST = 320, OVB = 64 * KST, BUF = OVB + 64 * VST;
    const int tid = otid(), wave = __builtin_amdgcn_readfirstlane(tid >> 6), lane = tid & 63, r = lane & 31, h = lane >> 5, g1 = (lane >> 4) & 1, q4 = (lane & 15) >> 2, p4 = lane & 3;
    const int G = (int)gridDim.x, vcu = (G == 256) ? ((int)blockIdx.x & 7) * 32 + ((int)blockIdx.x >> 3) : (int)blockIdx.x;
    for (int item = vcu; item < 1024; item += G) {
        const int bh = item >> 2, mbr = item & 3;
        const int b = bh >> 3, hd = bh & 7; const size_t rb = (size_t)b * LB;
        const char* knBase = (const char*)(Kn + rb * DM + hd * 128); const char* vBase = (const char*)(V + rb * DM + hd * 128); const unsigned krDelta = (unsigned)((const char*)(Kr + rb * 64) - knBase);
        const char* knM = (const char*)(KnM + hd * 128); const char* vM = (const char*)(VM + hd * 128); const unsigned krDeltaM = (unsigned)((const char*)KrM - knM);
        for (int uu = 0; uu < 2; ++uu) { const int qb = uu == 0 ? mbr + 1 : 8 - mbr;
            const int ntiles = 4 * qb + 1, cwv = 4 * (qb - 1) + 1 + (wave >> 1), q0 = (qb - 1) * 256;
            const bool active = true;
            const size_t qrow = rb + q0 + wave * 32 + r;
            bf16x8 qf[12];
            if (active) {
#pragma unroll
                for (int ks = 0; ks < 8; ++ks) qf[ks] = *(const bf16x8*)(Qn + qrow * DM + hd * 128 + 16 * ks + 8 * h);
#pragma unroll
                for (int ks = 0; ks < 4; ++ks) qf[8 + ks] = *(const bf16x8*)(Qr + qrow * 512 + hd * 64 + 16 * ks + 8 * h);
            } else {
#pragma unroll
                for (int ks = 0; ks < 12; ++ks) qf[ks] = (bf16x8){0, 0, 0, 0, 0, 0, 0, 0};
            }
            float mrun = -1.0e30f, lrun = 0.f;
            f32x16 O[4];
#pragma unroll
            for (int t = 0; t < 4; ++t)
#pragma unroll
                for (int e = 0; e < 16; ++e) O[t][e] = 0.f;
#define ATT_DMA(j, bufi) do { LAS unsigned char* bb_ = lds + (bufi) * BUF; const bool m0_ = (j) == 0; const char* kb0_ = m0_ ? knM : knBase; const char* vb0_ = m0_ ? vM : vBase; \
                const unsigned jn_ = m0_ ? 0u : (unsigned)((j) - 1) * 131072u, jr_ = m0_ ? krDeltaM : (unsigned)((j) - 1) * 8192u + krDelta; int ln_ = lane; asm volatile("" : "+v"(ln_)); \
                _Pragma("unroll") for (int i_ = 0; i_ < 6; ++i_) { const int I_ = wave + 8 * i_; \
                    if (I_ < 25) { const int o_ = I_ * 1024 + ln_ * 16, row_ = o_ / KST, seg_ = (o_ - row_ * KST) >> 4; const bool isr_ = seg_ >= 16 && seg_ < 24; \
                        const unsigned vo_ = isr_ ? jr_ + (unsigned)(row_ * 128 + (seg_ - 16) * 16) : jn_ + (unsigned)(row_ * 2048 + (seg_ < 16 ? seg_ * 16 : 0)); \
                        __builtin_amdgcn_global_load_lds((const unsigned*)(kb0_ + (size_t)vo_), (LAS unsigned*)(bb_ + I_ * 1024), 16, 0, 0); } \
                    else if (I_ < 45) { const int o_ = (I_ - 25) * 1024 + ln_ * 16, row_ = o_ / VST, seg_ = (o_ - row_ * VST) >> 4; \
                        const unsigned vo_ = jn_ + (unsigned)(row_ * 2048 + (seg_ < 16 ? seg_ * 16 : 0)); \
                        __builtin_amdgcn_global_load_lds((const unsigned*)(vb0_ + (size_t)vo_), (LAS unsigned*)(bb_ + OVB + (I_ - 25) * 1024), 16, 0, 0); } } } while (0)
#define ATT_DMA_WAIT(ahead) do { if (!(ahead)) asm volatile("s_waitcnt vmcnt(0)" ::: "memory"); else if (wave < 5) asm volatile("s_waitcnt vmcnt(6)" ::: "memory"); else asm volatile("s_waitcnt vmcnt(5)" ::: "memory"); } while (0)
            ATT_DMA(0, 0); if (ntiles > 1) ATT_DMA(1, 1); ATT_DMA_WAIT(ntiles > 1);
            asm volatile("s_waitcnt lgkmcnt(0)" ::: "memory"); __builtin_amdgcn_s_barrier(); asm volatile("" ::: "memory");
            for (int j = 0; j < ntiles; ++j) {
                const bool more = (j + 2 < ntiles);
                if (more) ATT_DMA(j + 2, (j + 2) % 3);
                if (active && j <= cwv) {
                    const LAS unsigned char* kb = lds + (j % 3) * BUF; const LAS unsigned char* vb = kb + OVB;
                    f32x16 s0, s1;
#pragma unroll
                    for (int e = 0; e < 16; ++e) { s0[e] = 0.f; s1[e] = 0.f; }
                    const LAS unsigned char* ka = kb + r * KST + 16 * h;
#define ATT_LDK(dst, g) do { _Pragma("unroll") for (int i_ = 0; i_ < 2; ++i_) { dst[2 * i_] = *(const LAS bf16x8*)(ka + 32 * (2 * (g) + i_)); dst[2 * i_ + 1] = *(const LAS bf16x8*)(ka + 32 * KST + 32 * (2 * (g) + i_)); } } while (0)
#define ATT_MMK(src, g) do { s0 = MFMA32(src[0], qf[2 * (g)], s0); s1 = MFMA32(src[1], qf[2 * (g)], s1); __builtin_amdgcn_sched_barrier(0); s0 = MFMA32(src[2], qf[2 * (g) + 1], s0); s1 = MFMA32(src[3], qf[2 * (g) + 1], s1); } while (0)
#define ATT_SB __builtin_amdgcn_sched_barrier(0)
                    bf16x8 kA[4], kB[4];
                    __builtin_amdgcn_s_setprio(2);
                    ATT_LDK(kA, 0); ATT_LDK(kB, 1); ATT_SB;
                    ATT_MMK(kA, 0); ATT_SB; ATT_LDK(kA, 2); ATT_SB;
                    ATT_MMK(kB, 1); ATT_SB; ATT_LDK(kB, 3); ATT_SB;
                    ATT_MMK(kA, 2); ATT_SB; ATT_LDK(kA, 4); ATT_SB;
                    ATT_MMK(kB, 3); ATT_SB; ATT_LDK(kB, 5); ATT_SB;
                    ATT_MMK(kA, 4); ATT_SB;
                    ATT_MMK(kB, 5); ATT_SB;
                    const LAS unsigned char* va = vb + (4 * h + q4) * VST + (16 * g1 + 4 * p4) * 2;
#define ATT_TR(d, off) "ds_read_b64_tr_b16 %" #d ", %8 offset:" #off "\n\t"
#define ATT_LDV(dst, kk) do { u32x2 a0_, a1_, a2_, a3_, a4_, a5_, a6_, a7_; const unsigned vaddr_ = (unsigned)(size_t)(va + 16 * VST * (kk)); \
        asm volatile("ds_read_b64_tr_b16 %0, %8\n\tds_read_b64_tr_b16 %1, %8 offset:2560\n\tds_read_b64_tr_b16 %2, %8 offset:64\n\tds_read_b64_tr_b16 %3, %8 offset:2624\n\t" \
                     "ds_read_b64_tr_b16 %4, %8 offset:128\n\tds_read_b64_tr_b16 %5, %8 offset:2688\n\tds_read_b64_tr_b16 %6, %8 offset:192\n\tds_read_b64_tr_b16 %7, %8 offset:2752" \
                     : "=&v"(a0_), "=&v"(a1_), "=&v"(a2_), "=&v"(a3_), "=&v"(a4_), "=&v"(a5_), "=&v"(a6_), "=&v"(a7_) : "v"(vaddr_) : "memory"); \
        dst[0] = cat8u(a0_, a1_); dst[1] = cat8u(a2_, a3_); dst[2] = cat8u(a4_, a5_); dst[3] = cat8u(a6_, a7_); } while (0)
#define ATT_WV(dst) asm volatile("s_waitcnt lgkmcnt(0)" : "+v"(dst[0]), "+v"(dst[1]), "+v"(dst[2]), "+v"(dst[3]) :: "memory")
                    bf16x8 vA[4], vB[4];
                    ATT_LDV(vA, 0); ATT_SB;
                    __builtin_amdgcn_s_setprio(0);
                    if (j == 0) {
#pragma unroll
                        for (int e = 0; e < 16; ++e) { s0[e] = -1.0e30f; if (e < 8) s1[e] = -1.0e30f; } }
                    float mx = s0[0];
#pragma unroll
                    for (int e = 1; e < 16; ++e) mx = fmaxf(mx, s0[e]);
#pragma unroll
                    for (int e = 0; e < 16; ++e) mx = fmaxf(mx, s1[e]);
                    { const u32x2 sw_ = __builtin_amdgcn_permlane32_swap(__float_as_uint(mx), __float_as_uint(mx), false, false); mx = fmaxf(__uint_as_float(sw_.x), __uint_as_float(sw_.y)); }
                    const float mnew = fmaxf(mrun, mx), alpha = ex2(mrun - mnew); mrun = mnew;
                    float rs = 0.f;
#pragma unroll
                    for (int e = 0; e < 16; ++e) { s0[e] = ex2(s0[e] - mnew); s1[e] = ex2(s1[e] - mnew); rs += s0[e] + s1[e]; }
                    { const u32x2 sw_ = __builtin_amdgcn_permlane32_swap(__float_as_uint(rs), __float_as_uint(rs), false, false); rs = __uint_as_float(sw_.x) + __uint_as_float(sw_.y); } lrun = lrun * alpha + rs;
#pragma unroll
                    for (int t = 0; t < 4; ++t) O[t] *= alpha;
                    const bf16x8 pb0 = pack_acc<0>(s0), pb1 = pack_acc<8>(s0), pb2 = pack_acc<0>(s1), pb3 = pack_acc<8>(s1);
#define ATT_MMV(src, pb) do { O[0] = MFMA32(src[0], pb, O[0]); O[1] = MFMA32(src[1], pb, O[1]); O[2] = MFMA32(src[2], pb, O[2]); O[3] = MFMA32(src[3], pb, O[3]); } while (0)
                    __builtin_amdgcn_s_setprio(2);
                    ATT_SB; ATT_WV(vA); ATT_LDV(vB, 1); ATT_SB;
                    ATT_MMV(vA, pb0); ATT_SB;
                    ATT_WV(vB); ATT_LDV(vA, 2); ATT_SB;
                    ATT_MMV(vB, pb1); ATT_SB;
                    ATT_WV(vA); ATT_LDV(vB, 3); ATT_SB;
                    ATT_MMV(vA, pb2); ATT_SB;
                    ATT_WV(vB); ATT_SB;
                    ATT_MMV(vB, pb3);
                    __builtin_amdgcn_s_setprio(0);
#undef ATT_WV
#undef ATT_TR
#undef ATT_LDK
#undef ATT_SB
#undef ATT_MMK
#undef ATT_LDV
#undef ATT_MMV
                }
                ATT_DMA_WAIT(more);
                asm volatile("s_waitcnt lgkmcnt(0)" ::: "memory"); __builtin_amdgcn_s_barrier(); asm volatile("" ::: "memory");
            }
#undef ATT_DMA
#undef ATT_DMA_WAIT
            if (active) { const float inv = 1.0f / lrun; bf16_t* od = AO + qrow * DM + hd * 128 + 4 * h;
#pragma unroll
                for (int t = 0; t < 4; ++t)
#pragma unroll
                    for (int g4 = 0; g4 < 4; ++g4) { u32x2 w; w.x = pk2(O[t][4 * g4] * inv, O[t][4 * g4 + 1] * inv); w.y = pk2(O[t][4 * g4 + 2] * inv, O[t][4 * g4 + 3] * inv);
                        *(u32x2*)(od + 32 * t + 8 * g4) = w; } }
        }
    }
}

DI void final_phase(const Params& p) {
    const int tid = otid(), lane = tid & 63, gw = blockIdx.x * 8 + (tid >> 6), nw = gridDim.x * 8;
    const float* SSQ = (const float*)(p.ws + OFF_SSQ);
    f32x4 g[4];
#pragma unroll
    for (int c = 0; c < 4; ++c) g[c] = *(const f32x4*)(p.final_g + c * 256 + lane * 4);
    for (int rf = gw; rf < NB * SEQ; rf += 2 * nw) {
        const int rf2 = rf + nw; const bool has2 = rf2 < NB * SEQ; const int rfb = has2 ? rf2 : rf;
        float* o0 = p.out + ((size_t)rf << 10); float* o1 = p.out + ((size_t)rfb << 10);
        f32x4 v0[4], v1[4];
#pragma unroll
        for (int c = 0; c < 4; ++c) { v0[c] = *(const f32x4*)(o0 + c * 256 + lane * 4); v1[c] = *(const f32x4*)(o1 + c * 256 + lane * 4); }
        const float r0 = rsqrtf(SSQ[rf] * (1.0f / 1024.0f) + RMS_EPS), r1 = rsqrtf(SSQ[rfb] * (1.0f / 1024.0f) + RMS_EPS);
#pragma unroll
        for (int c = 0; c < 4; ++c) *(f32x4*)(o0 + c * 256 + lane * 4) = v0[c] * r0 * g[c];
        if (has2) {
#pragma unroll
            for (int c = 0; c < 4; ++c) *(f32x4*)(o1 + c * 256 + lane * 4) = v1[c] * r1 * g[c]; } }
}

#define XB_TMO      128
#define XB_XCNT(j)  (256  + 64 * (j))
#define XB_XSUB(j)  (1280 + 64 * (j))
#define XB_XGEN(j)  (2304 + 64 * (j))
#define XB_TOP      3328
#define XB_TOPGEN   3392
#define XCD_BAR_WORDS 3456
#define XB_SPIN_CAP (1u << 22)

__device__ __forceinline__ unsigned xb_ld(unsigned* p)              { return __hip_atomic_load(p, __ATOMIC_RELAXED, __HIP_MEMORY_SCOPE_AGENT); }
__device__ __forceinline__ unsigned xb_add(unsigned* p, unsigned v) { return __hip_atomic_fetch_add(p, v, __ATOMIC_RELAXED, __HIP_MEMORY_SCOPE_AGENT); }
__device__ __forceinline__ unsigned xb_xcc_id() { return (unsigned)__builtin_amdgcn_s_getreg((3 << 11) | 20) & 0xFu; }
#define XB_SPIN(cond, bar) do { unsigned _sp = 0; while (cond) { __builtin_amdgcn_s_sleep(1); \
    if ((++_sp & 255u) == 0u) { if (xb_ld(&(bar)[XB_TMO])) break; if (_sp > XB_SPIN_CAP) { atomicAdd(&(bar)[XB_TMO], 1u); break; } } } } while (0)

struct XcdBarrier {
    unsigned* bar; unsigned x;
    volatile LAS unsigned* st;
};

__device__ __forceinline__ XcdBarrier xcd_barrier_post(unsigned* bar, volatile LAS unsigned* st) {
    XcdBarrier b; b.bar = bar; b.x = xb_xcc_id(); b.st = st;
    if (threadIdx.x == 0) (void)xb_add(&bar[XB_XCNT(b.x)], 1u);
    return b;
}
__device__ __forceinline__ void xcd_barrier_complete(unsigned* bar, unsigned x, unsigned& nloc, unsigned& nx) {
    const unsigned G = gridDim.x * gridDim.y * gridDim.z;
    unsigned sum, cnt, mine, sp = 0u;
    for (;;) {
        sum = 0u; cnt = 0u; mine = 0u;
#pragma unroll
        for (unsigned j = 0; j < 16; ++j) { const unsigned c = xb_ld(&bar[XB_XCNT(j)]); sum += c; cnt += (c > 0u) ? 1u : 0u; mine = (j == x) ? c : mine; }
        if (sum == G) break;
        __builtin_amdgcn_s_sleep(1);
        if ((++sp & 255u) == 0u) { if (xb_ld(&bar[XB_TMO])) break; if (sp > XB_SPIN_CAP) { atomicAdd(&bar[XB_TMO], 1u); break; } }
    }
    nloc = mine > 0u ? mine : 1u; nx = cnt > 0u ? cnt : 1u;
}

__device__ __forceinline__ void xcd_barrier(const XcdBarrier& b) {
    asm volatile("s_waitcnt vmcnt(0)" ::: "memory");
    __syncthreads();
    if (threadIdx.x == 0) {
        unsigned* bar = b.bar;
        __builtin_amdgcn_s_waitcnt(0);
        unsigned nloc = b.st[0], nx = b.st[1];
        if (nloc == 0u) { xcd_barrier_complete(bar, b.x, nloc, nx); b.st[0] = nloc; b.st[1] = nx; }
        const unsigned old = xb_add(&bar[XB_XSUB(b.x)], 1u);
        const unsigned gen = old / nloc;
        if (old + 1u == (gen + 1u) * nloc) {
            __builtin_amdgcn_fence(__ATOMIC_RELEASE, "agent");
            asm volatile("s_waitcnt vmcnt(0)" ::: "memory");
            const unsigned og = xb_add(&bar[XB_TOP], 1u);
            const unsigned tg = og / nx;
            if (og + 1u == (tg + 1u) * nx) xb_add(&bar[XB_TOPGEN], 1u);
            else XB_SPIN(xb_ld(&bar[XB_TOPGEN]) == tg, bar);
            __builtin_amdgcn_fence(__ATOMIC_ACQUIRE, "agent");
            xb_add(&bar[XB_XGEN(b.x)], 1u);
            asm volatile("s_waitcnt vmcnt(0)" ::: "memory");
        } else {
            XB_SPIN(xb_ld(&bar[XB_XGEN(b.x)]) == gen, bar);
            __builtin_amdgcn_fence(__ATOMIC_ACQUIRE, "agent");
            asm volatile("s_waitcnt vmcnt(0)" ::: "memory");
        }
    }
    __syncthreads();
}

DI void gbar(LAS unsigned char* lds);
DI float rb16(float v) { return __uint_as_float(pk2(v, 0.f) << 16); }
template <int K> DI void skinny(LAS unsigned char* lds, const bf16_t* Bt, const int N, float* C) {
    constexpr int NIT = (K + 511) / 512;
    const int tid = otid(), lane = tid & 63, gw = blockIdx.x * 8 + (tid >> 6), nw = gridDim.x * 8;
    for (int n = gw; n < N; n += nw) {
        float acc[16];
#pragma unroll
        for (int r = 0; r < 16; ++r) acc[r] = 0.f;
        u32x4 bw[NIT];
#pragma unroll
        for (int it = 0; it < NIT; ++it) { const int k0 = lane * 8 + 512 * it; bw[it] = (u32x4){0u, 0u, 0u, 0u}; if (k0 < K) bw[it] = *(const u32x4*)(Bt + (size_t)n * K + k0); }
#pragma unroll
        for (int it = 0; it < NIT; ++it) { const int k0 = lane * 8 + 512 * it;
            if (k0 < K) { const float b0 = bflo(bw[it].x), b1 = bfhi(bw[it].x), b2 = bflo(bw[it].y), b3 = bfhi(bw[it].y), b4 = bflo(bw[it].z), b5 = bfhi(bw[it].z), b6 = bflo(bw[it].w), b7 = bfhi(bw[it].w);
#pragma unroll
                for (int r = 0; r < 16; ++r) { const u32x4 aw = *(const LAS u32x4*)(lds + LDS_MA + (r * K + k0) * 2);
                    acc[r] += (bflo(aw.x) * b0 + bfhi(aw.x) * b1) + (bflo(aw.y) * b2 + bfhi(aw.y) * b3) + (bflo(aw.z) * b4 + bfhi(aw.z) * b5) + (bflo(aw.w) * b6 + bfhi(aw.w) * b7); } } }
#pragma unroll
        for (int k = 0; k < 8; ++k) { const bool hi = lane & 1; const float snd = hi ? acc[k] : acc[k + 8], kp = hi ? acc[k + 8] : acc[k]; acc[k] = kp + __shfl_xor(snd, 1); }
#pragma unroll
        for (int k = 0; k < 4; ++k) { const bool hi = lane & 2; const float snd = hi ? acc[k] : acc[k + 4], kp = hi ? acc[k + 4] : acc[k]; acc[k] = kp + __shfl_xor(snd, 2); }
#pragma unroll
        for (int k = 0; k < 2; ++k) { const bool hi = lane & 4; const float snd = hi ? acc[k] : acc[k + 2], kp = hi ? acc[k + 2] : acc[k]; acc[k] = kp + __shfl_xor(snd, 4); }
        { const bool hi = lane & 8; const float snd = hi ? acc[0] : acc[1], kp = hi ? acc[1] : acc[0]; acc[0] = kp + __shfl_xor(snd, 8); }
        float t = acc[0]; t += __shfl_xor(t, 16); t += __shfl_xor(t, 32);
        if (lane < 16) C[(8 * (lane & 1) + 4 * ((lane >> 1) & 1) + 2 * ((lane >> 2) & 1) + ((lane >> 3) & 1)) * N + n] = t;
    }
}
DI void meta_hm(LAS unsigned char* lds, const float* hsrc, const float* C, float* hdst) {
    const int tid = otid(), lane = tid & 63, wave = tid >> 6;
    LAS bf16_t* As = (LAS bf16_t*)(lds + LDS_MA); LAS float* RS = (LAS float*)(lds + LDS_MRS);
#pragma unroll
    for (int u = 0; u < 2; ++u) { const int r = 2 * wave + u; float ss = 0.f;
#pragma unroll
        for (int c = 0; c < 4; ++c) { const int col = c * 256 + lane * 4; f32x4 v = *(const f32x4*)(hsrc + r * 1024 + col); if (C) v += *(const f32x4*)(C + r * 1024 + col);
            if (hdst) *(f32x4*)(hdst + r * 1024 + col) = v;
            ss += (v[0] * v[0] + v[1] * v[1]) + (v[2] * v[2] + v[3] * v[3]);
            u32x2 w; w.x = pk2(v[0], v[1]); w.y = pk2(v[2], v[3]); *(LAS u32x2*)(As + r * 1024 + col) = w; }
        ss = wsum(ss); if (lane == 0) RS[r] = rsqrtf(ss * (1.0f / 1024.0f) + RMS_EPS); }
    __syncthreads();
}
DI void meta_front(const Params& p, LAS unsigned char* lds) {
    const int tid = otid(), lane = tid & 63, wave = tid >> 6, gt = blockIdx.x * 512 + tid, ntot = gridDim.x * 512;
    unsigned char* ws = p.ws;
    float* Cg0 = (float*)(ws + OFF_CM); float* Cg1 = Cg0 + 98304; float* Pm = (float*)(ws + OFF_PM); float* S0g = (float*)(ws + OFF_S0); float* HMg = (float*)(ws + OFF_HMG);
    const float* cosr = (const float*)(ws + OFF_COSR); const float* sinr = (const float*)(ws + OFF_SINR);
    const bf16_t* W1 = (const bf16_t*)(ws + OFF_W1);
    LAS bf16_t* As = (LAS bf16_t*)(lds + LDS_MA); LAS bf16_t* Ob = (LAS bf16_t*)(lds + LDS_MO); LAS float* RS = (LAS float*)(lds + LDS_MRS); float* SCg = (float*)(ws + OFF_SCG);
    int cur = 0;
    meta_hm(lds, p.meta, nullptr, HMg);
    for (int l = 0; l < 2; ++l) {
        const int tid = otid(), lane = tid & 63, wave = tid >> 6, gt = blockIdx.x * 512 + tid;
        const bf16_t* wl = W1 + l * W1_LAYER;
        { float* Cg = Cg0; skinny<1024>(lds, wl, RIN, Cg); gbar(lds);
        for (int idx = gt; idx < 16 * RIN; idx += ntot) { const int r = idx / RIN, n = idx - r * RIN; const float rs = RS[r]; float v = Cg[idx] * rs;
            if (n < 2048) { const int i = n & 127, n1 = n & ~128; const float x1 = Cg[r * RIN + n1] * rs, x2 = Cg[r * RIN + n1 + 128] * rs, c = cosr[r * 128 + i], sn = sinr[r * 128 + i];
                v = (n & 128) ? x1 * sn + x2 * c : x1 * c - x2 * sn; }
            Pm[idx] = rb16(v); }
        gbar(lds); }
        for (int idx = gt; idx < 4 * 256 * 512; idx += ntot) { const int hd = idx >> 17, d = (idx >> 9) & 255, c = idx & 511; const float lg2 = log2f(1.0f - exp2f(-5.0f - (float)hd)); float a = 0.f;
#pragma unroll 4
            for (int j = 0; j < 16; ++j) a += Pm[j * RIN + 1024 + hd * 256 + d] * rb16(Pm[j * RIN + 2048 + hd * 512 + c] * ex2(lg2 * (float)(15 - j)));
            S0g[(size_t)l * 524288 + idx] = a; }
        for (int t = blockIdx.x * 8 + wave; t < 1024; t += gridDim.x * 8) { const int hd = t >> 8, i = (t >> 4) & 15, j = t & 15; const float lg2 = log2f(1.0f - exp2f(-5.0f - (float)hd));
            const f32x4 qv = *(const f32x4*)(Pm + i * RIN + hd * 256 + lane * 4), kv = *(const f32x4*)(Pm + j * RIN + 1024 + hd * 256 + lane * 4);
            const float a = wsum((qv[0] * kv[0] + qv[1] * kv[1]) + (qv[2] * kv[2] + qv[3] * kv[3]));
            if (lane == 0) SCg[t] = rb16(a * ex2(lg2 * fabsf((float)(i - j)))); }
        gbar(lds);
        { LAS bf16_t* Vs = (LAS bf16_t*)(lds + LDS_MA); LAS float* SCs = (LAS float*)(lds + LDS_MA + 65536);
          for (int t = tid; t < 1024; t += 512) SCs[t] = SCg[t];
#pragma unroll 4
          for (int q = tid; q < 16 * 512; q += 512) { const int i = q >> 9, c4 = (q & 511) * 4; const f32x4 v = *(const f32x4*)(Pm + i * RIN + 2048 + c4);
              u32x2 w; w.x = pk2(v[0], v[1]); w.y = pk2(v[2], v[3]); *(LAS u32x2*)(Vs + i * 2048 + c4) = w; }
          __syncthreads();
          for (int idx = tid; idx < 16 * 2048; idx += 512) { const int i = idx >> 11, c = idx & 2047, hd = c >> 9; float a = 0.f;
#pragma unroll
              for (int j = 0; j < 16; ++j) a += SCs[hd * 256 + i * 16 + j] * __uint_as_float((unsigned)Vs[j * 2048 + c] << 16);
              Ob[idx] = (bf16_t)(pk2(a, 0.f) & 0xffffu); }
          __syncthreads(); }
        for (int task = wave; task < 64; task += 8) { const int i = task >> 2, hd = task & 3; const LAS bf16_t* po = Ob + i * 2048 + hd * 512 + lane * 8; float o[8]; float sm = 0.f;
#pragma unroll
            for (int e = 0; e < 8; ++e) { o[e] = __uint_as_float((unsigned)po[e] << 16); sm += o[e]; }
            const float mu = wsum(sm) * (1.0f / 512.0f); float q = 0.f;
#pragma unroll
            for (int e = 0; e < 8; ++e) { o[e] -= mu; q += o[e] * o[e]; }
            const float rstd = rsqrtf(wsum(q) * (1.0f / 512.0f) + GN_EPS);
#pragma unroll
            for (int e = 0; e < 8; ++e) { const int c = hd * 512 + lane * 8 + e; const float g = Pm[i * RIN + 4096 + c];
                As[i * 2048 + c] = (bf16_t)(pk2(silu_f(g) * (o[e] * rstd * p.ret_gn_g[l * 2048 + c]), 0.f) & 0xffffu); } }
        __syncthreads();
        skinny<2048>(lds, wl + W1_WO, 1024, Cg1); gbar(lds);
        meta_hm(lds, HMg + cur * 16384, Cg1, HMg + (cur ^ 1) * 16384); cur ^= 1;
        skinny<1024>(lds, wl + W1_WUP, 5632, Cg0); gbar(lds);
#pragma unroll 2
        for (int q = tid; q < 16 * (FFH / 4); q += 512) { const int r = q / (FFH / 4), c = (q - r * (FFH / 4)) * 4, g = c >> 7, j = c & 127; const float rs = RS[r];
            const f32x4 a = *(const f32x4*)(Cg0 + r * 5632 + (2 * g) * 128 + j) * rs, b = *(const f32x4*)(Cg0 + r * 5632 + (2 * g + 1) * 128 + j) * rs;
            u32x2 w; w.x = pk2(silu_f(a[0]) * b[0], silu_f(a[1]) * b[1]); w.y = pk2(silu_f(a[2]) * b[2], silu_f(a[3]) * b[3]); *(LAS u32x2*)(As + r * FFH + c) = w; }
        __syncthreads();
        skinny<FFH>(lds, wl + W1_WDN, 1024, Cg1); gbar(lds);
        meta_hm(lds, HMg + cur * 16384, Cg1, HMg + (cur ^ 1) * 16384); cur ^= 1;
    }
}
DI void meta_kv(const Params& p, LAS unsigned char* lds) {
    const int tid = otid(), lane = tid & 63, wave = tid >> 6;
    unsigned char* ws = p.ws;
    float* Cg0 = (float*)(ws + OFF_CM); float* Cg1 = Cg0 + 98304; const float* HMg = (const float*)(ws + OFF_HMG);
    const float* cosm = (const float*)(ws + OFF_COSM); const float* sinm = (const float*)(ws + OFF_SINM);
    const bf16_t* W2 = (const bf16_t*)(ws + OFF_W2);
    bf16_t* KnM = (bf16_t*)(ws + OFF_KNM); bf16_t* VM = (bf16_t*)(ws + OFF_VM); bf16_t* KrM = (bf16_t*)(ws + OFF_KRM);
    LAS bf16_t* As = (LAS bf16_t*)(lds + LDS_MA); LAS float* RS = (LAS float*)(lds + LDS_MRS);
    meta_hm(lds, HMg, nullptr, nullptr);
    skinny<1024>(lds, W2, 768, Cg0); gbar(lds);
#pragma unroll
    for (int u = 0; u < 2; ++u) { const int r = 2 * wave + u; const float rs = RS[r]; float v[8]; float ss = 0.f;
#pragma unroll
        for (int e = 0; e < 8; ++e) { v[e] = Cg0[r * 768 + lane * 8 + e] * rs; ss += v[e] * v[e]; }
        ss = wsum(ss);
#pragma unroll
        for (int e = 0; e < 8; ++e) As[r * 512 + lane * 8 + e] = (bf16_t)(pk2(v[e], 0.f) & 0xffffu);
        if (lane == 0) RS[16 + r] = rsqrtf(ss * (1.0f / 512.0f) + RMS_EPS);
        if (lane < 32) { const float x1 = Cg0[r * 768 + 512 + lane] * rs, x2 = Cg0[r * 768 + 640 + lane] * rs, c = cosm[r * 32 + lane], sn = sinm[r * 32 + lane];
            KrM[(48 + r) * 64 + lane] = (bf16_t)(pk2(x1 * c - x2 * sn, 0.f) & 0xffffu); KrM[(48 + r) * 64 + 32 + lane] = (bf16_t)(pk2(x1 * sn + x2 * c, 0.f) & 0xffffu); } }
    for (int idx = tid; idx < 48 * 1024; idx += 512) { KnM[idx] = 0; VM[idx] = 0; }
    for (int idx = tid; idx < 48 * 64; idx += 512) KrM[idx] = 0;
    __syncthreads();
    skinny<512>(lds, W2 + W2_KVB, 2048, Cg1); gbar(lds);
    for (int idx = tid; idx < 16 * 2048; idx += 512) { const int r = idx >> 11, n = idx & 2047, head = n >> 8, j = n & 255; const float v = Cg1[idx] * RS[16 + r];
        bf16_t* dst = (j < 128 ? KnM : VM) + (48 + r) * 1024 + head * 128 + (j & 127); *dst = (bf16_t)(pk2(v, 0.f) & 0xffffu); }
    __syncthreads();
}

typedef const __attribute__((address_space(4))) Params* KArgP;
DI Params ldp() {
#if defined(__HIP_DEVICE_COMPILE__)
    KArgP kp = (KArgP)__builtin_amdgcn_kernarg_segment_ptr(); asm volatile("" : "+s"(kp));
    Params r; const __attribute__((address_space(4))) unsigned long long* s = (const __attribute__((address_space(4))) unsigned long long*)kp; unsigned long long* d = (unsigned long long*)&r;
#pragma unroll
    for (int i = 0; i < (int)(sizeof(Params) / 8); ++i) d[i] = s[i];
    return r;
#else
    return Params{};
#endif
}
#ifndef PHM
#define PHM 0xffff
#endif
#ifndef PHD
#define PHD 0
#endif
#define WSP(T, off) ((T*)(ws + (off)))
DI void zero_rs(float* rs) { int st = (int)gridDim.x * 512; asm volatile("" : "+s"(st)); float z = 0.f; asm volatile("" : "+v"(z)); for (int i = (int)blockIdx.x * 512 + otid(); i < MR; i += st) rs[i] = z; }
DI void ph_win(LAS unsigned char* lds, int l) { const Params p = ldp(); unsigned char* ws = p.ws; zero_rs(WSP(float, OFF_SSQ) + MR);
    EpiWin E{WSP(bf16_t, OFF_PROJ), WSP(float, OFF_SSQ), WSP(float, OFF_COSR), WSP(float, OFF_SINR)}; run_gemm(lds, WSP(bf16_t, OFF_HB), DM, WSP(bf16_t, OFF_W1) + l * W1_LAYER, RIN, 1024, E); }
DI void ph_res(LAS unsigned char* lds, const bf16_t* A, int lda, const bf16_t* Bt, int K, bool first, bool mixer) { const Params p = ldp(); unsigned char* ws = p.ws;
    if (mixer) zero_rs(WSP(float, OFF_SSQ));
    EpiRes E{first ? p.x : p.out, p.out, WSP(float, OFF_HM), WSP(bf16_t, OFF_HB), WSP(float, OFF_SSQ) + (mixer ? MR : 0)}; run_gemm(lds, A, lda, Bt, 1024, K, E); }
DI void ph_up(LAS unsigned char* lds, const bf16_t* Bt) { const Params p = ldp(); unsigned char* ws = p.ws;
    EpiUp E{WSP(bf16_t, OFF_U), WSP(float, OFF_SSQ) + MR}; run_gemm(lds, WSP(bf16_t, OFF_HB), DM, Bt, 5632, 1024, E); }
DI void ph_null(LAS unsigned char* lds, const bf16_t* A, int lda, const bf16_t* Bt, int N, int K) { const Params p = ldp(); unsigned char* ws = p.ws;
    EpiNull E{WSP(float, OFF_SSQ2)}; run_gemm(lds, A, lda, Bt, N, K, E); }
DI void ph_kva(LAS unsigned char* lds) { const Params p = ldp(); unsigned char* ws = p.ws;
    EpiKva E{WSP(bf16_t, OFF_CKV), WSP(bf16_t, OFF_KR), WSP(float, OFF_SSQ), WSP(float, OFF_SSQ2), WSP(float, OFF_COSM), WSP(float, OFF_SINM)}; run_gemm(lds, WSP(bf16_t, OFF_HB), DM, WSP(bf16_t, OFF_W2), 768, 1024, E); }
DI void ph_qa(LAS unsigned char* lds, int jj) { const Params p = ldp(); unsigned char* ws = p.ws; zero_rs(WSP(float, OFF_SSQ) + MR);
    EpiQa E{WSP(bf16_t, OFF_CQ), WSP(float, OFF_SSQ), WSP(float, OFF_SSQ3)}; run_gemm(lds, WSP(bf16_t, OFF_HB), DM, WSP(bf16_t, OFF_W2) + W2_L0 + jj * W2_LAYER, 768, 1024, E); }
DI void ph_kvb(LAS unsigned char* lds) { const Params p = ldp(); unsigned char* ws = p.ws;
    EpiKvb E{WSP(bf16_t, OFF_KN), WSP(bf16_t, OFF_V), WSP(float, OFF_SSQ2)}; run_gemm(lds, WSP(bf16_t, OFF_CKV), 512, WSP(bf16_t, OFF_W2) + W2_KVB, 2048, 512, E); }
DI void ph_qb(LAS unsigned char* lds, int jj) { const Params p = ldp(); unsigned char* ws = p.ws;
    EpiQb E{WSP(bf16_t, OFF_QN), WSP(bf16_t, OFF_QR), WSP(float, OFF_SSQ3), WSP(float, OFF_COSM), WSP(float, OFF_SINM)}; run_gemm(lds, WSP(bf16_t, OFF_CQ), 768, WSP(bf16_t, OFF_W2) + W2_L0 + jj * W2_LAYER + W2_WQB, 1536, 768, E); }
DI void ph_attn(LAS unsigned char* lds) { const Params p = ldp(); unsigned char* ws = p.ws;
    attn_phase(lds, WSP(bf16_t, OFF_QN), WSP(bf16_t, OFF_QR), WSP(bf16_t, OFF_KN), WSP(bf16_t, OFF_KR), WSP(bf16_t, OFF_V), WSP(bf16_t, OFF_AO), WSP(bf16_t, OFF_KNM), WSP(bf16_t, OFF_KRM), WSP(bf16_t, OFF_VM)); }

DI void gbar(LAS unsigned char* lds) { const Params p = ldp(); XcdBarrier b; b.bar = (unsigned*)(p.ws + OFF_BAR); b.x = xb_xcc_id(); b.st = (volatile LAS unsigned*)(lds + LDS_XB); xcd_barrier(b); }

__global__ void __launch_bounds__(512, 2) yoco_fwd(Params p_unused) {
    extern __shared__ __attribute__((aligned(16))) unsigned char shm[];
    LAS unsigned char* lds = (LAS unsigned char*)shm;
    cg::grid_group grid = cg::this_grid();
    if (threadIdx.x < 4) ((volatile LAS unsigned*)(lds + LDS_XB))[threadIdx.x] = 0u;
    __syncthreads();
    { const Params p = ldp(); (void)xcd_barrier_post((unsigned*)(p.ws + OFF_BAR), (volatile LAS unsigned*)(lds + LDS_XB)); }
    if (PHM & 1) { const Params p = ldp(); prologue_rows(p); }
    if (PHM & 2) { const Params p = ldp(); convert_set1(p, lds); }
    grid.sync();
    { const Params p = ldp(); meta_front(p, lds); }
    if (PHD & 131072) { const Params p = ldp(); meta_front(p, lds); }
    for (int l = 0; l < 2; ++l) {
        if (PHM & 4) ph_win(lds, l);
        if (PHD & 4) ph_win(lds, l);
        gbar(lds);
        if (PHM & 8) { const Params p = ldp(); ret_phase<false>(lds, (bf16_t*)(p.ws + OFF_PROJ), nullptr, (const float*)(p.ws + OFF_S0) + (size_t)l * 524288); }
        if (PHD & 8) { const Params p = ldp(); ret_phase<true>(lds, (bf16_t*)(p.ws + OFF_PROJ), (bf16_t*)(p.ws + OFF_HB), (const float*)(p.ws + OFF_S0) + (size_t)l * 524288); }
        gbar(lds);
        if (PHM & 16) { const Params p = ldp(); gn_phase(p, l, (bf16_t*)(p.ws + OFF_PROJ)); }
        gbar(lds);
        if (PHM & 32) { const Params p = ldp(); unsigned char* ws = p.ws; ph_res(lds, WSP(bf16_t, OFF_PROJ) + 4096, RIN, WSP(bf16_t, OFF_W1) + l * W1_LAYER + W1_WO, 2048, l == 0, true); }
        gbar(lds);
        if (PHM & 64) { const Params p = ldp(); unsigned char* ws = p.ws; ph_up(lds, WSP(bf16_t, OFF_W1) + l * W1_LAYER + W1_WUP); }
        if (PHD & 64) { const Params p = ldp(); unsigned char* ws = p.ws; ph_up(lds, WSP(bf16_t, OFF_W1) + l * W1_LAYER + W1_WUP); }
        if (PHD & 8192) { const Params p = ldp(); unsigned char* ws = p.ws; ph_null(lds, WSP(bf16_t, OFF_HB), DM, WSP(bf16_t, OFF_W1) + l * W1_LAYER + W1_WUP, 5632, 1024); }
        gbar(lds);
        if (PHD & 16384) { const Params p = ldp(); unsigned char* ws = p.ws; ph_null(lds, WSP(bf16_t, OFF_U), FFH, WSP(bf16_t, OFF_W1) + l * W1_LAYER + W1_WDN, 1024, FFH); }
        if (PHM & 32) { const Params p = ldp(); unsigned char* ws = p.ws; ph_res(lds, WSP(bf16_t, OFF_U), FFH, WSP(bf16_t, OFF_W1) + l * W1_LAYER + W1_WDN, FFH, false, false); }
        if ((PHM & 2) && l == 1) { const Params p = ldp(); const int nfive = 1056 - 4 * (int)gridDim.x; if (nfive <= 0 || nfive >= (int)gridDim.x) convert_set2(p, lds, (int)blockIdx.x, (int)gridDim.x); else if ((int)blockIdx.x >= nfive) convert_set2(p, lds, (int)blockIdx.x - nfive, (int)gridDim.x - nfive); }
        gbar(lds);
    }
    { const Params p = ldp(); meta_kv(p, lds); }
    for (int jj = 0; jj < 2; ++jj) {
        if ((PHM & 128) && jj == 0) ph_kva(lds);
        if (PHM & 256) ph_qa(lds, jj);
        gbar(lds);
        if ((PHM & 512) && jj == 0) ph_kvb(lds);
        if (PHM & 1024) ph_qb(lds, jj);
        gbar(lds);
        if (PHM & 2048) ph_attn(lds);
        if (PHD & 2048) ph_attn(lds);
        gbar(lds);
        if (PHM & 32) { const Params p = ldp(); unsigned char* ws = p.ws; ph_res(lds, WSP(bf16_t, OFF_AO), DM, WSP(bf16_t, OFF_W2) + W2_L0 + jj * W2_LAYER + W2_WOM, 1024, false, true); }
        gbar(lds);
        if (PHM & 64) { const Params p = ldp(); unsigned char* ws = p.ws; ph_up(lds, WSP(bf16_t, OFF_W2) + W2_L0 + jj * W2_LAYER + W2_WUP); }
        if (PHD & 64) { const Params p = ldp(); unsigned char* ws = p.ws; ph_up(lds, WSP(bf16_t, OFF_W2) + W2_L0 + jj * W2_LAYER + W2_WUP); }
        if (PHD & 8192) { const Params p = ldp(); unsigned char* ws = p.ws; ph_null(lds, WSP(bf16_t, OFF_HB), DM, WSP(bf16_t, OFF_W2) + W2_L0 + jj * W2_LAYER + W2_WUP, 5632, 1024); }
        gbar(lds);
        if (PHD & 16384) { const Params p = ldp(); unsigned char* ws = p.ws; ph_null(lds, WSP(bf16_t, OFF_U), FFH, WSP(bf16_t, OFF_W2) + W2_L0 + jj * W2_LAYER + W2_WDN, 1024, FFH); }
        if (PHM & 32) { const Params p = ldp(); unsigned char* ws = p.ws; ph_res(lds, WSP(bf16_t, OFF_U), FFH, WSP(bf16_t, OFF_W2) + W2_L0 + jj * W2_LAYER + W2_WDN, FFH, false, false); }
        gbar(lds);
    }
    if (PHD & 32768) { for (int k = 0; k < 40; ++k) gbar(lds); }
    if (PHM & 4096) { const Params p = ldp(); final_phase(p); }
}

extern "C" void kernel_launch(void* const* d_in, const int* in_sizes, int n_in, void* d_out, int out_size, void* d_ws, size_t ws_size, hipStream_t stream) {
    static int grid = 0;
    if (grid == 0) {
        if (n_in != 19 || out_size != NB * SEQ * DM || ws_size < WS_END2) { fprintf(stderr, "kernel_launch: unexpected shapes (n_in %d out %d ws %zu)\n", n_in, out_size, ws_size); grid = -1; return; }
        int dev = 0, cus = 0, per_cu = 0;
        (void)hipGetDevice(&dev); (void)hipDeviceGetAttribute(&cus, hipDeviceAttributeMultiprocessorCount, dev);
        (void)hipFuncSetAttribute((const void*)yoco_fwd, hipFuncAttributeMaxDynamicSharedMemorySize, LDS_BYTES);
        (void)hipOccupancyMaxActiveBlocksPerMultiprocessor(&per_cu, (const void*)yoco_fwd, 512, LDS_BYTES);
        if (per_cu < 1) per_cu = 1;
        grid = cus * per_cu;
    }
    if (grid < 0) return;
    (void)hipMemsetAsync((unsigned char*)d_ws + OFF_BAR, 0, XCD_BAR_WORDS * 4, stream);
    Params p{};
    const float** f = (const float**)&p;
    for (int i = 0; i < 19; ++i) f[i] = (const float*)d_in[i];
    p.out = (float*)d_out; p.ws = (unsigned char*)d_ws;
    void* args[] = {&p};
    hipError_t e = hipLaunchCooperativeKernel((const void*)yoco_fwd, dim3(grid), dim3(512), args, LDS_BYTES, stream);
    if (e != hipSuccess) fprintf(stderr, "cooperative launch failed: %s (grid %d)\n", hipGetErrorString(e), grid);
}
```

```cpp
#include <hip/hip_runtime.h>
#include <hip/hip_cooperative_groups.h>
#include <cstdio>
namespace cg = cooperative_groups;

namespace pg8 {
#define PG8_LAS __attribute__((address_space(3)))
typedef unsigned short bf16_t;
typedef short bf16x8 __attribute__((ext_vector_type(8)));
typedef float f32x4 __attribute__((ext_vector_type(4)));
typedef unsigned u32x4 __attribute__((ext_vector_type(4)));
constexpr int BM = 256, BK = 64, HALF = 128, HTB = HALF * BK * 2  , STAGE_BYTES = 8 * HTB, NXCD = 8, WGM = 8;

__host__ __device__ __forceinline__ int lds_byte(int r, int c) { const int st = (r >> 4) * 2 + (c >> 5), rr = r & 15, cc = c & 31, ob = rr * 64 + cc * 2; return st * 1024 + (ob ^ (((ob >> 9) & 1) << 5)); }
__host__ __device__ __forceinline__ void stage_rc(int b, int& R, int& C) { const int st = b / 1024, sb = b % 1024, swz = sb ^ (((sb >> 9) & 1) << 5); R = (st >> 1) * 16 + swz / 64; C = (st & 1) * 32 + (swz % 64) / 2; }
__host__ __device__ __forceinline__ int perm32(int rho) { const int n = rho >> 4, i = rho & 15; return 8 * (i >> 2) + 4 * n + (i & 3); }
struct Unit { int pm, pn; };
struct Gemm { const bf16_t* A; const bf16_t* Bt; int M, N, K, lda; };
struct StaticOrder {
    int nM, nN, nwg, G, c;
    __host__ __device__ void init(int M, int N, int G_, int c_) { nM = M / BM; nN = N / BM; nwg = nM * nN; G = G_; c = c_; }
    __host__ __device__ bool next(int i, Unit& u) const {
        const int L = i * G + c; if (L >= nwg) return false;
        int wgid = L; { const int q = nwg / NXCD, r = nwg % NXCD, xcd = wgid % NXCD, off = wgid / NXCD; wgid = (xcd < r ? xcd * (q + 1) : r * (q + 1) + (xcd - r) * q) + off; }
        const int nig = WGM * nN, gid = wgid / nig, fm = gid * WGM, gsz = (nM - fm) < WGM ? (nM - fm) : WGM;
        u.pm = fm + ((wgid % nig) % gsz); u.pn = (wgid % nig) / gsz; return true;
    }
    __device__ __forceinline__ void a_ready(const Unit&) const {}
    __device__ __forceinline__ void done(const Unit&) const {}
};
template <class Epi, class Sched>
__device__ __forceinline__ void gemm_phase(PG8_LAS unsigned char* lds, const Gemm g, const Sched& S, const Epi& E) {
    int tid_ = threadIdx.x; asm volatile("" : "+v"(tid_));
    const int tid = tid_, wid = __builtin_amdgcn_readfirstlane(tid >> 6), lane = tid & 63, wr = wid >> 2, wc = wid & 3, fr = lane & 15, fq = lane >> 4;
    const int K = g.K, nt = K / BK;
    unsigned voffA[2], voffB[2];
#pragma unroll
    for (int i = 0; i < 2; ++i) { int R, C; stage_rc(tid * 16 + i * 8192, R, C); const int Rb = Epi::PERM ? ((R & ~31) + perm32(R & 31)) : R;
        voffA[i] = (unsigned)(R * g.lda + C) * 2u; voffB[i] = (unsigned)(Rb * K + C) * 2u; }
    const size_t kstep = (size_t)(BK * 2);
    const size_t hstepA = (size_t)HALF * g.lda * 2, hstepB = (size_t)HALF * K * 2;
    const size_t tstepA = 2 * hstepA, tstepB = 2 * hstepB;
    const unsigned ldsw = (unsigned)wid * 1024u;
    const int aoff = lds_byte(wr * 64 + fr, fq * 8), boff = lds_byte(wc * 32 + fr, fq * 8);
#define PG8_SA(b, h) (((b) * 2 + (h)) * HTB)
#define PG8_SB(b, h) ((4 + (b) * 2 + (h)) * HTB)
#define PG8_STAGE(bufoff, gbase, voff) do { _Pragma("unroll") for (int _i = 0; _i < 2; ++_i) \
        __builtin_amdgcn_global_load_lds((const unsigned*)((const char*)(gbase) + (voff)[_i]), (PG8_LAS unsigned*)(lds + (bufoff) + ldsw + _i * 8192), 16, 0, 0); } while (0)
#define PG8_LDA(dst, b, h) do { _Pragma("unroll") for (int m = 0; m < 4; ++m) _Pragma("unroll") for (int k = 0; k < 2; ++k) dst[m][k] = *(const PG8_LAS bf16x8*)(lds + PG8_SA(b, h) + aoff + m * 2048 + k * 1024); } while (0)
#define PG8_LDB(dst, b, h) do { _Pragma("unroll") for (int n = 0; n < 2; ++n) _Pragma("unroll") for (int k = 0; k < 2; ++k) dst[n][k] = *(const PG8_LAS bf16x8*)(lds + PG8_SB(b, h) + boff + n * 2048 + k * 1024); } while (0)
#define PG8_MMA(ai, bj, At, Bt) do { __builtin_amdgcn_s_setprio(1); _Pragma("unroll") for (int m = 0; m < 4; ++m) _Pragma("unroll") for (int n = 0; n < 2; ++n) _Pragma("unroll") for (int k = 0; k < 2; ++k) \
        acc[ai][bj][m][n] = __builtin_amdgcn_mfma_f32_16x16x32_bf16(Bt[n][k], At[m][k], acc[ai][bj][m][n], 0, 0, 0); __builtin_amdgcn_s_setprio(0); } while (0)
#define PG8_WAIT_V(n) asm volatile("s_waitcnt vmcnt(" #n ")" ::: "memory")
#define PG8_WAIT_L(n) asm volatile("s_waitcnt lgkmcnt(" #n ")" ::: "memory")
#define PG8_BAR __builtin_amdgcn_s_barrier()
#define PG8_SCHED __builtin_amdgcn_sched_barrier(0)
    Unit cur, nxt; int ui = 0;
    typename Epi::Pre pre;
    if (!S.next(0, cur)) return;
    f32x4 acc[2][2][4][2];
#pragma unroll
    for (int a = 0; a < 2; ++a)
#pragma unroll
        for (int b = 0; b < 2; ++b)
#pragma unroll
            for (int m = 0; m < 4; ++m)
#pragma unroll
                for (int n = 0; n < 2; ++n) acc[a][b][m][n] = (f32x4){0.f, 0.f, 0.f, 0.f};
    bf16x8 At[4][2], B0[2][2], B1[2][2];
    const char* cA = (const char*)g.A + (size_t)cur.pm * tstepA; const char* cB = (const char*)g.Bt + (size_t)cur.pn * tstepB;
    S.a_ready(cur);
    PG8_STAGE(PG8_SB(0, 0), cB, voffB); PG8_STAGE(PG8_SA(0, 0), cA, voffA); PG8_STAGE(PG8_SB(0, 1), cB + hstepB, voffB); PG8_STAGE(PG8_SA(0, 1), cA + hstepA, voffA);
    if (wr == 1) PG8_BAR;
    PG8_WAIT_V(4); PG8_BAR;
    PG8_STAGE(PG8_SB(1, 0), cB + kstep, voffB); PG8_STAGE(PG8_SA(1, 0), cA + kstep, voffA); PG8_STAGE(PG8_SB(1, 1), cB + hstepB + kstep, voffB);
    PG8_WAIT_V(6); PG8_BAR;
    for (;;) {
        const bool has_next = S.next(ui + 1, nxt);
        const char* nA = has_next ? (const char*)g.A + (size_t)nxt.pm * tstepA : cA; const char* nB = has_next ? (const char*)g.Bt + (size_t)nxt.pn * tstepB : cB;
        for (int t = 0; t < nt; t += 2) {
            const bool last = (t == nt - 2);
            const char* a1 = cA + (size_t)(t + 1) * kstep;
            const char* a2 = last ? nA : cA + (size_t)(t + 2) * kstep; const char* b2 = last ? nB : cB + (size_t)(t + 2) * kstep;
            const char* a3 = a2 + kstep; const char* b3 = b2 + kstep;
            if (last && has_next) S.a_ready(nxt);
            if (last) E.prefetch(pre, cur, wr, fr, fq);
            PG8_LDB(B0, 0, 0); PG8_SCHED; PG8_LDA(At, 0, 0); PG8_STAGE(PG8_SA(1, 1), a1 + hstepA, voffA);
            PG8_WAIT_L(8); PG8_BAR; PG8_WAIT_L(0); PG8_MMA(0, 0, At, B0); PG8_BAR; PG8_SCHED;
            PG8_LDB(B1, 0, 1); PG8_STAGE(PG8_SB(0, 0), b2, voffB);
            PG8_BAR; PG8_WAIT_L(0); PG8_MMA(0, 1, At, B1); PG8_BAR;
            PG8_LDA(At, 0, 1); PG8_STAGE(PG8_SA(0, 0), a2, voffA);
            PG8_BAR; PG8_WAIT_L(0); PG8_MMA(1, 0, At, B0); PG8_BAR; PG8_SCHED;
            PG8_STAGE(PG8_SB(0, 1), b2 + hstepB, voffB);
            PG8_WAIT_V(6); PG8_BAR; PG8_MMA(1, 1, At, B1); PG8_BAR;
            PG8_LDB(B0, 1, 0); PG8_SCHED; PG8_LDA(At, 1, 0); PG8_STAGE(PG8_SA(0, 1), a2 + hstepA, voffA);
            PG8_WAIT_L(8); PG8_BAR; PG8_WAIT_L(0); PG8_MMA(0, 0, At, B0); PG8_BAR; PG8_SCHED;
            PG8_LDB(B1, 1, 1); PG8_STAGE(PG8_SB(1, 0), b3, voffB);
            PG8_BAR; PG8_WAIT_L(0); PG8_MMA(0, 1, At, B1); PG8_BAR;
            PG8_LDA(At, 1, 1); PG8_STAGE(PG8_SA(1, 0), a3, voffA);
            PG8_BAR; PG8_WAIT_L(0); PG8_MMA(1, 0, At, B0); PG8_BAR; PG8_SCHED;
            PG8_STAGE(PG8_SB(1, 1), b3 + hstepB, voffB);
            PG8_WAIT_V(6); PG8_BAR; PG8_MMA(1, 1, At, B1); PG8_BAR;
        }
        if constexpr (!Epi::AFTER_DRAIN) { E(acc, pre, cur, wr, wc, fr, fq); S.done(cur); }
        if (!has_next) break;
#pragma unroll
        for (int a = 0; a < 2; ++a)
#pragma unroll
            for (int b = 0; b < 2; ++b)
#pragma unroll
                for (int m = 0; m < 4; ++m)
#pragma unroll
                    for (int n = 0; n < 2; ++n) acc[a][b][m][n] = (f32x4){0.f, 0.f, 0.f, 0.f};
        cur = nxt; cA = nA; cB = nB; ++ui;
    }
    PG8_WAIT_V(0);
    if (wr == 0) PG8_BAR;
    PG8_BAR;
#undef PG8_SA
#undef PG8_SB
#undef PG8_STAGE
#undef PG8_LDA
#undef PG8_LDB
#undef PG8_MMA
#undef PG8_WAIT_V
#undef PG8_WAIT_L
#undef PG8_BAR
#undef PG8_SCHED
}
}

using pg8::bf16_t; using pg8::bf16x8; using pg8::f32x4; using pg8::u32x4;
typedef float f32x16 __attribute__((ext_vector_type(16)));
typedef float f32x2 __attribute__((ext_vector_type(2)));
typedef short s16x4 __attribute__((ext_vector_type(4)));
typedef unsigned u32x2 __attribute__((ext_vector_type(2)));
typedef __bf16 bf2_t __attribute__((ext_vector_type(2)));
typedef short v4i16_t __attribute__((ext_vector_type(4)));
#define LAS __attribute__((address_space(3)))
#define DI __device__ __forceinline__

constexpr int NB = 32, SEQ = 2048, DM = 1024, LB = 2048  , MR = NB * LB  , NPOS = 2064, FFH = 2816, RIN = 6144;
constexpr float RMS_EPS = 1e-6f, GN_EPS = 1e-5f;
constexpr size_t OFF_PROJ = 0;
constexpr size_t OFF_U = 0, OFF_CQ = 0, OFF_CKV = 103809024ull, OFF_AO = 0, OFF_QN = 173015040ull, OFF_QR = 311427072ull;
constexpr size_t OFF_KN = 380633088ull, OFF_V = 519045120ull, OFF_KR = 657457152ull, OFF_W2 = 666107904ull;
constexpr size_t OFF_HB = 830472192ull, OFF_W1 = 968884224ull, OFF_HM = 1037041664ull, OFF_SSQ = 1045430272ull, OFF_SSQ2 = 1049755648ull, OFF_SSQ3 = 1051918336ull;
constexpr size_t OFF_COSR = 1056243712ull, OFF_SINR = 1057325056ull, OFF_COSM = 1058406400ull, OFF_SINM = 1058676736ull, WS_END = 1058947072ull;
constexpr size_t W1_LAYER = 17039360ull, W1_WO = 6291456ull, W1_WUP = 8388608ull, W1_WDN = 14155776ull;
constexpr size_t W2_KVB = 786432ull, W2_L0 = 1835008ull, W2_LAYER = 11665408ull, W2_WQB = 786432ull, W2_WOM = 1966080ull, W2_WUP = 3014656ull, W2_WDN = 8781824ull;
constexpr int LDS_MA = 0, LDS_MO = 90112, LDS_MRS = 155648;
constexpr int LDS_XB = 155904;
constexpr int LDS_BYTES = LDS_XB + 16;
constexpr size_t OFF_BAR = WS_END, OFF_S0 = WS_END + 16384  , OFF_CM = OFF_S0 + 4194304  , OFF_PM = OFF_CM + 786432, OFF_HMG = OFF_PM + 393216  ,
    OFF_KNM = OFF_HMG + 131072  , OFF_VM = OFF_KNM + 131072, OFF_KRM = OFF_VM + 131072  , OFF_SCG = OFF_KRM + 8192  , WS_END2 = OFF_SCG + 4096;

struct Params {
    const float *x, *meta, *norm_mix_g, *norm_ffn_g, *ret_w_in, *ret_gn_g, *ret_w_o, *mla_norm_kv_g, *mla_w_kv_a, *mla_kv_a_norm_g, *mla_w_kv_b,
        *mla_w_q_a, *mla_q_a_norm_g, *mla_w_q_b, *mla_w_o, *ffn_w1, *ffn_w3, *ffn_w2, *final_g;
    float* out; unsigned char* ws;
};

DI unsigned pk2(float a, float b) { f32x2 v = {a, b}; bf2_t r = __builtin_convertvector(v, bf2_t); return __builtin_bit_cast(unsigned, r); }
DI u32x4 pk8(f32x4 a, f32x4 b) { u32x4 w; w.x = pk2(a[0], a[1]); w.y = pk2(a[2], a[3]); w.z = pk2(b[0], b[1]); w.w = pk2(b[2], b[3]); return w; }
DI float bflo(unsigned w) { return __uint_as_float(w << 16); }
DI float bfhi(unsigned w) { return __uint_as_float(w & 0xffff0000u); }
DI float ex2(float x) { return __builtin_amdgcn_exp2f(x); }
DI float wsum(float v) { v += __shfl_xor(v, 1); v += __shfl_xor(v, 2); v += __shfl_xor(v, 4); v += __shfl_xor(v, 8); v += __shfl_xor(v, 16); v += __shfl_xor(v, 32); return v; }
DI float sum4(const float* p, int n4) { float s = 0.f; for (int i = 0; i < n4; ++i) { const f32x4 a = *(const f32x4*)(p + 4 * i); s += (a[0] + a[1]) + (a[2] + a[3]); } return s; }
DI float silu_f(float a) { return a * __builtin_amdgcn_rcpf(1.0f + ex2(-1.4426950408889634f * a)); }
DI s16x4 vtr(const LAS unsigned char* p) { return __builtin_bit_cast(s16x4, __builtin_amdgcn_ds_read_tr16_b64_v4i16((LAS v4i16_t*)p)); }
DI bf16x8 cat8(s16x4 lo, s16x4 hi) { return __builtin_shufflevector(lo, hi, 0, 1, 2, 3, 4, 5, 6, 7); }
DI bf16x8 cat8u(u32x2 lo, u32x2 hi) { u32x4 w; w.x = lo.x; w.y = lo.y; w.z = hi.x; w.w = hi.y; return __builtin_bit_cast(bf16x8, w); }
#define MFMA32(a, b, c) __builtin_amdgcn_mfma_f32_32x32x16_bf16((a), (b), (c), 0, 0, 0)
#define MFMA16(a, b, c) __builtin_amdgcn_mfma_f32_16x16x32_bf16((a), (b), (c), 0, 0, 0)
template <int S8> DI bf16x8 pack_acc(const f32x16& x) { u32x4 w; w.x = pk2(x[S8 + 0], x[S8 + 1]); w.y = pk2(x[S8 + 2], x[S8 + 3]); w.z = pk2(x[S8 + 4], x[S8 + 5]); w.w = pk2(x[S8 + 6], x[S8 + 7]); return __builtin_bit_cast(bf16x8, w); }

DI const float* hrow_c(const float* frames, const float*, int row) { return frames + ((size_t)row << 10); }
DI float* hrow_m(float* frames, float*, int row) { return frames + ((size_t)row << 10); }

#define EPI_FOR_ROWS _Pragma("unroll") for (int ai = 0; ai < 2; ++ai) _Pragma("unroll") for (int m = 0; m < 4; ++m)
#define EPI_ROW (u.pm * 256 + ai * 128 + wr * 64 + m * 16 + fr)
typedef const f32x4 (&AccRef)[2][2][4][2];
struct PreNone {};
struct PreRstd { float v[8]; };
DI void rstd_load(PreRstd& pre, const float* rs, int row0) {
#pragma unroll
    for (int k = 0; k < 8; ++k) pre.v[k] = rs[row0 + (k >> 2) * 128 + (k & 3) * 16];
}
DI void rstd_reduce(float (&r)[8], const PreRstd& pre, float invn) {
#pragma unroll
    for (int k = 0; k < 8; ++k) r[k] = rsqrtf(pre.v[k] * invn + RMS_EPS);
}
template <int NQ, int STR> DI void rstd_rows(float (&rs)[8], const float* ssq, int row0, int fq, float invn) {
    f32x4 pt[8];
    const int fql = (NQ == 4 || fq < NQ) ? fq : 0; const float keep = (NQ == 4 || fq < NQ) ? 1.0f : 0.0f;
#pragma unroll
    for (int k = 0; k < 8; ++k) { const int row = row0 + (k >> 2) * 128 + (k & 3) * 16; pt[k] = *(const f32x4*)(ssq + (size_t)row * STR + 4 * fql); }
#pragma unroll
    for (int k = 0; k < 8; ++k) { float s = ((pt[k][0] + pt[k][1]) + (pt[k][2] + pt[k][3])) * keep; s += __shfl_xor(s, 16); s += __shfl_xor(s, 32); rs[k] = rsqrtf(s * invn + RMS_EPS); }
}
DI void rope8(u32x4& lo, u32x4& hi, f32x4 x1a, f32x4 x1b, f32x4 x2a, f32x4 x2b, f32x4 c0, f32x4 c1, f32x4 s0, f32x4 s1) {
    lo = pk8(x1a * c0 - x2a * s0, x1b * c1 - x2b * s1); hi = pk8(x1a * s0 + x2a * c0, x1b * s1 + x2b * c1); }

struct EpiWin {
    static constexpr bool PERM = true, AFTER_DRAIN = false; typedef PreRstd Pre;
    bf16_t* P; const float* ssq; const float* cosr; const float* sinr;
    DI void prefetch(Pre& pre, const pg8::Unit& u, int wr, int fr, int fq) const { rstd_load(pre, ssq, u.pm * 256 + wr * 64 + fr); }
    DI void operator()(AccRef acc, const Pre& pre, const pg8::Unit& u, int wr, int wc, int fr, int fq) const {
        asm volatile("" : "+v"(fr), "+v"(fq));
        const int cb = wc * 32 + 8 * fq, row0 = u.pm * 256 + wr * 64 + fr;
        float rs[8]; rstd_reduce(rs, pre, 1.0f / 1024.0f);
        if (u.pn < 8) {
#pragma unroll
            for (int aim = 0; aim < 4; ++aim) { const int ai = aim >> 1, mb = (aim & 1) * 2; f32x4 c0[4], c1[4], s0[4], s1[4];
#pragma unroll
                for (int m = mb; m < mb + 2; ++m) { const int i = (EPI_ROW & 2047) + 16;     const float* cp = cosr + i * 128 + cb; const float* sp = sinr + i * 128 + cb;
                    c0[m] = *(const f32x4*)cp; c1[m] = *(const f32x4*)(cp + 4); s0[m] = *(const f32x4*)sp; s1[m] = *(const f32x4*)(sp + 4); }
#pragma unroll
                for (int m = mb; m < mb + 2; ++m) { const float r = rs[ai * 4 + m]; bf16_t* dst = P + (size_t)EPI_ROW * RIN + u.pn * 256 + cb; u32x4 lo, hi;
                    rope8(lo, hi, acc[ai][0][m][0] * r, acc[ai][0][m][1] * r, acc[ai][1][m][0] * r, acc[ai][1][m][1] * r, c0[m], c1[m], s0[m], s1[m]);
                    *(u32x4*)dst = lo; *(u32x4*)(dst + 128) = hi; } }
        } else {
            EPI_FOR_ROWS { const float r = rs[ai * 4 + m]; bf16_t* dst = P + (size_t)EPI_ROW * RIN + u.pn * 256 + cb;
                *(u32x4*)dst = pk8(acc[ai][0][m][0] * r, acc[ai][0][m][1] * r); *(u32x4*)(dst + 128) = pk8(acc[ai][1][m][0] * r, acc[ai][1][m][1] * r); } }
    }
};
struct EpiRes {
    static constexpr bool PERM = true, AFTER_DRAIN = false; typedef PreNone Pre;
    DI void prefetch(Pre&, const pg8::Unit&, int, int, int) const {}
    const float* src_fr; float* dst_fr; float* hm; bf16_t* HB; float* ssq;
    DI void operator()(AccRef acc, const Pre&, const pg8::Unit& u, int wr, int wc, int fr, int fq) const {
        asm volatile("" : "+v"(fr), "+v"(fq));
        const int cb = u.pn * 256 + wc * 32 + 8 * fq;
#pragma unroll
        for (int ai = 0; ai < 2; ++ai) { f32x4 hv[4][4];
#pragma unroll
            for (int m = 0; m < 4; ++m) { const float* s = hrow_c(src_fr, hm, EPI_ROW) + cb; hv[m][0] = *(const f32x4*)s; hv[m][1] = *(const f32x4*)(s + 4); hv[m][2] = *(const f32x4*)(s + 128); hv[m][3] = *(const f32x4*)(s + 132); }
#pragma unroll
            for (int m = 0; m < 4; ++m) { const int row = EPI_ROW; float* d = hrow_m(dst_fr, hm, row) + cb; float ss = 0.f;
#pragma unroll
                for (int bj = 0; bj < 2; ++bj) { const f32x4 h0 = hv[m][2 * bj] + acc[ai][bj][m][0], h1 = hv[m][2 * bj + 1] + acc[ai][bj][m][1];
                    *(f32x4*)(d + bj * 128) = h0; *(f32x4*)(d + bj * 128 + 4) = h1; *(u32x4*)(HB + (size_t)row * DM + cb + bj * 128) = pk8(h0, h1);
                    ss += (h0[0] * h0[0] + h0[1] * h0[1]) + (h0[2] * h0[2] + h0[3] * h0[3]) + (h1[0] * h1[0] + h1[1] * h1[1]) + (h1[2] * h1[2] + h1[3] * h1[3]); }
                ss += __shfl_xor(ss, 16); ss += __shfl_xor(ss, 32);
                if (fq == 0) unsafeAtomicAdd(ssq + row, ss); } }
    }
};
struct EpiUp {
    static constexpr bool PERM = true, AFTER_DRAIN = false; typedef PreRstd Pre;
    bf16_t* U; const float* ssq;
    DI void prefetch(Pre& pre, const pg8::Unit& u, int wr, int fr, int fq) const { rstd_load(pre, ssq, u.pm * 256 + wr * 64 + fr); }
    DI void operator()(AccRef acc, const Pre& pre, const pg8::Unit& u, int wr, int wc, int fr, int fq) const {
        asm volatile("" : "+v"(fr), "+v"(fq));
        const int cb = u.pn * 128 + wc * 32 + 8 * fq, row0 = u.pm * 256 + wr * 64 + fr;
        float rs[8]; rstd_reduce(rs, pre, 1.0f / 1024.0f);
        EPI_FOR_ROWS { const float r = rs[ai * 4 + m], k1 = -1.4426950408889634f * r, rr = r * r; f32x4 o0, o1;
            const f32x4 p0 = acc[ai][0][m][0] * acc[ai][1][m][0] * rr, p1 = acc[ai][0][m][1] * acc[ai][1][m][1] * rr, m0 = acc[ai][0][m][0] * k1, m1 = acc[ai][0][m][1] * k1;
#pragma unroll
            for (int e = 0; e < 4; ++e) { o0[e] = p0[e] * __builtin_amdgcn_rcpf(1.0f + ex2(m0[e])); o1[e] = p1[e] * __builtin_amdgcn_rcpf(1.0f + ex2(m1[e])); }
            *(u32x4*)(U + (size_t)EPI_ROW * FFH + cb) = pk8(o0, o1); }
    }
};
struct EpiKva {
    static constexpr bool PERM = true, AFTER_DRAIN = false; typedef PreRstd Pre;
    bf16_t* CKV; bf16_t* Kr; const float* ssq; float* ssq2; const float* cosm; const float* sinm;
    DI void prefetch(Pre& pre, const pg8::Unit& u, int wr, int fr, int fq) const { rstd_load(pre, ssq, u.pm * 256 + wr * 64 + fr); }
    DI void operator()(AccRef acc, const Pre& pre, const pg8::Unit& u, int wr, int wc, int fr, int fq) const {
        asm volatile("" : "+v"(fr), "+v"(fq));
        const int row0 = u.pm * 256 + wr * 64 + fr;
        float rs[8]; rstd_reduce(rs, pre, 1.0f / 1024.0f);
        if (u.pn < 2) {
            EPI_FOR_ROWS { const int row = EPI_ROW; const float r = rs[ai * 4 + m];
                const f32x4 x1a = acc[ai][0][m][0] * r, x1b = acc[ai][0][m][1] * r, x2a = acc[ai][1][m][0] * r, x2b = acc[ai][1][m][1] * r;
                bf16_t* dst = CKV + (size_t)row * 512 + u.pn * 256 + wc * 32 + 8 * fq; *(u32x4*)dst = pk8(x1a, x1b); *(u32x4*)(dst + 128) = pk8(x2a, x2b);
                float ss = 0.f;
#pragma unroll
                for (int e = 0; e < 4; ++e) ss += x1a[e] * x1a[e] + x1b[e] * x1b[e] + x2a[e] * x2a[e] + x2b[e] * x2b[e];
                ss += __shfl_xor(ss, 16); ss += __shfl_xor(ss, 32);
                if (fq == 0) ssq2[(size_t)row * 8 + u.pn * 4 + wc] = ss; }
        } else if (wc == 0) { const int f0 = 8 * fq;
#pragma unroll
            for (int aim = 0; aim < 4; ++aim) { const int ai = aim >> 1, mb = (aim & 1) * 2; f32x4 c0[4], c1[4], s0[4], s1[4];
#pragma unroll
                for (int m = mb; m < mb + 2; ++m) { const int i = (EPI_ROW & 2047) + 16;     const float* cp = cosm + i * 32 + f0; const float* sp = sinm + i * 32 + f0;
                    c0[m] = *(const f32x4*)cp; c1[m] = *(const f32x4*)(cp + 4); s0[m] = *(const f32x4*)sp; s1[m] = *(const f32x4*)(sp + 4); }
#pragma unroll
                for (int m = mb; m < mb + 2; ++m) { const float r = rs[ai * 4 + m]; bf16_t* dst = Kr + (size_t)EPI_ROW * 64 + f0; u32x4 lo, hi;
                    rope8(lo, hi, acc[ai][0][m][0] * r, acc[ai][0][m][1] * r, acc[ai][1][m][0] * r, acc[ai][1][m][1] * r, c0[m], c1[m], s0[m], s1[m]);
                    *(u32x4*)dst = lo; *(u32x4*)(dst + 32) = hi; } } }
    }
};
struct EpiKvb {
    static constexpr bool PERM = true, AFTER_DRAIN = false; typedef PreNone Pre;
    bf16_t* Kn; bf16_t* V; const float* ssq2;
    DI void prefetch(Pre&, const pg8::Unit&, int, int, int) const {}
    DI void operator()(AccRef acc, const Pre&, const pg8::Unit& u, int wr, int wc, int fr, int fq) const {
        asm volatile("" : "+v"(fr), "+v"(fq));
        const int cb = u.pn * 128 + wc * 32 + 8 * fq, row0 = u.pm * 256 + wr * 64 + fr;
        float rs[8]; rstd_rows<2, 8>(rs, ssq2, row0, fq, 1.0f / 512.0f);
        EPI_FOR_ROWS { const int row = EPI_ROW; const float r = rs[ai * 4 + m];
            *(u32x4*)(Kn + (size_t)row * DM + cb) = pk8(acc[ai][0][m][0] * r, acc[ai][0][m][1] * r); *(u32x4*)(V + (size_t)row * DM + cb) = pk8(acc[ai][1][m][0] * r, acc[ai][1][m][1] * r); }
    }
};
struct EpiQa {
    static constexpr bool PERM = true, AFTER_DRAIN = false; typedef PreRstd Pre;
    bf16_t* CQ; const float* ssq; float* ssq3;
    DI void prefetch(Pre& pre, const pg8::Unit& u, int wr, int fr, int fq) const { rstd_load(pre, ssq, u.pm * 256 + wr * 64 + fr); }
    DI void operator()(AccRef acc, const Pre& pre, const pg8::Unit& u, int wr, int wc, int fr, int fq) const {
        asm volatile("" : "+v"(fr), "+v"(fq));
        const int row0 = u.pm * 256 + wr * 64 + fr;
        float rs[8]; rstd_reduce(rs, pre, 1.0f / 1024.0f);
        EPI_FOR_ROWS { const int row = EPI_ROW; const float r = rs[ai * 4 + m];
            const f32x4 x1a = acc[ai][0][m][0] * r, x1b = acc[ai][0][m][1] * r, x2a = acc[ai][1][m][0] * r, x2b = acc[ai][1][m][1] * r;
            bf16_t* dst = CQ + (size_t)row * 768 + u.pn * 256 + wc * 32 + 8 * fq; *(u32x4*)dst = pk8(x1a, x1b); *(u32x4*)(dst + 128) = pk8(x2a, x2b);
            float ss = 0.f;
#pragma unroll
            for (int e = 0; e < 4; ++e) ss += x1a[e] * x1a[e] + x1b[e] * x1b[e] + x2a[e] * x2a[e] + x2b[e] * x2b[e];
            ss += __shfl_xor(ss, 16); ss += __shfl_xor(ss, 32);
            if (fq == 0) ssq3[(size_t)row * 16 + u.pn * 4 + wc] = ss; }
    }
};
struct EpiQb {
    static constexpr bool PERM = true, AFTER_DRAIN = false; typedef PreNone Pre;
    bf16_t* Qn; bf16_t* Qr; const float* ssq3; const float* cosm; const float* sinm;
    DI void prefetch(Pre&, const pg8::Unit&, int, int, int) const {}
    DI void operator()(AccRef acc, const Pre&, const pg8::Unit& u, int wr, int wc, int fr, int fq) const {
        asm volatile("" : "+v"(fr), "+v"(fq));
        const int row0 = u.pm * 256 + wr * 64 + fr;
        float rs[8]; rstd_rows<3, 16>(rs, ssq3, row0, fq, 1.0f / 768.0f);
        if (u.pn < 4) {
            EPI_FOR_ROWS { const float r = rs[ai * 4 + m]; bf16_t* dst = Qn + (size_t)EPI_ROW * DM + u.pn * 256 + wc * 32 + 8 * fq;
                *(u32x4*)dst = pk8(acc[ai][0][m][0] * r, acc[ai][0][m][1] * r); *(u32x4*)(dst + 128) = pk8(acc[ai][1][m][0] * r, acc[ai][1][m][1] * r); }
        } else { const int f0 = 8 * fq, head = 4 * (u.pn - 4) + wc;
#pragma unroll
            for (int aim = 0; aim < 4; ++aim) { const int ai = aim >> 1, mb = (aim & 1) * 2; f32x4 c0[4], c1[4], s0[4], s1[4];
#pragma unroll
                for (int m = mb; m < mb + 2; ++m) { const int i = (EPI_ROW & 2047) + 16;     const float* cp = cosm + i * 32 + f0; const float* sp = sinm + i * 32 + f0;
                    c0[m] = *(const f32x4*)cp; c1[m] = *(const f32x4*)(cp + 4); s0[m] = *(const f32x4*)sp; s1[m] = *(const f32x4*)(sp + 4); }
#pragma unroll
                for (int m = mb; m < mb + 2; ++m) { const float r = rs[ai * 4 + m]; bf16_t* dst = Qr + (size_t)EPI_ROW * 512 + head * 64 + f0; u32x4 lo, hi;
                    rope8(lo, hi, acc[ai][0][m][0] * r, acc[ai][0][m][1] * r, acc[ai][1][m][0] * r, acc[ai][1][m][1] * r, c0[m], c1[m], s0[m], s1[m]);
                    *(u32x4*)dst = lo; *(u32x4*)(dst + 32) = hi; } } }
    }
};
struct EpiNull { static constexpr bool PERM = true, AFTER_DRAIN = false; typedef PreNone Pre;
    DI void prefetch(Pre&, const pg8::Unit&, int, int, int) const {} float* sink;
    DI void operator()(AccRef acc, const Pre&, const pg8::Unit& u, int wr, int wc, int fr, int fq) const { float s = 0.f;
        EPI_FOR_ROWS { s += acc[ai][0][m][0][0] + acc[ai][1][m][1][3] + acc[ai][0][m][1][2] + acc[ai][1][m][0][1]; }
        if (s == 123.456f) sink[0] = s; } };
template <class Epi> DI void run_gemm(LAS unsigned char* lds, const bf16_t* A, int lda, const bf16_t* Bt, int N, int K, const Epi& E) {
    pg8::Gemm g{A, Bt, MR, N, K, lda}; pg8::StaticOrder S; S.init(MR, N, (int)gridDim.x, (int)blockIdx.x);
    pg8::gemm_phase<Epi, pg8::StaticOrder>(lds, g, S, E);
}

DI int wmap(int type, int n, int& which, float& nscale) {
    which = 0; nscale = 1.0f;
    if (type == 0) return n;
    if (type == 1) { if (n >= 1024 && n < 2048) nscale = 0.0625f; return n; }
    if (type == 2) { const int g = n >> 8, s = (n >> 7) & 1, j = n & 127; which = s; return g * 128 + j; }
    if (type == 3) { if (n < 512) return n; const int c = n - 512; if (c < 32) return 512 + c; if (c >= 128 && c < 160) return 544 + (c - 128); return -1; }
      { if (n < 1024) { const int head = n >> 7, dim = n & 127; return head * 192 + dim; }
        const int c0 = n - 1024, tt = c0 >> 8, c = c0 & 255, half = c >> 7, c1 = c & 127, hh = c1 >> 5, i = c1 & 31, head = 4 * tt + hh; return head * 192 + 128 + 32 * half + i; }
}
DI int otid() { int t = threadIdx.x; asm volatile("" : "+v"(t)); return t; }
DI void convert_job(const float* jsrc, const float* jsrc2, const float* jgain, bf16_t* jdst, const int jK, const int jNsrc, const int jN, const int jtype, const float jscale, LAS unsigned char* lds, const int first, const int stride) {
    const int tid = otid(), nTk = jK >> 6, ntiles = (jN >> 6) * nTk;
    LAS bf16_t* T = (LAS bf16_t*)lds;
    for (int tile = first; tile < ntiles; tile += stride) {
        const int tn = tile / nTk, tk = tile - tn * nTk, n0 = tn * 64, k0 = tk * 64;
        { const int kl = tid >> 3, n8 = (tid & 7) * 8; int which; float ns; const int sc = wmap(jtype, n0 + n8, which, ns);
          f32x4 a = {0.f, 0.f, 0.f, 0.f}, b = a;
          if (sc >= 0) { const float* s = (which ? jsrc2 : jsrc) + (size_t)(k0 + kl) * jNsrc + sc; a = *(const f32x4*)s; b = *(const f32x4*)(s + 4);
              const float f = (jgain ? jgain[k0 + kl] : 1.0f) * jscale * ns; a *= f; b *= f; }
          const unsigned w0 = pk2(a[0], a[1]), w1 = pk2(a[2], a[3]), w2 = pk2(b[0], b[1]), w3 = pk2(b[2], b[3]);
          T[(n8 + 0) * 72 + kl] = (bf16_t)(w0 & 0xffffu); T[(n8 + 1) * 72 + kl] = (bf16_t)(w0 >> 16); T[(n8 + 2) * 72 + kl] = (bf16_t)(w1 & 0xffffu); T[(n8 + 3) * 72 + kl] = (bf16_t)(w1 >> 16);
          T[(n8 + 4) * 72 + kl] = (bf16_t)(w2 & 0xffffu); T[(n8 + 5) * 72 + kl] = (bf16_t)(w2 >> 16); T[(n8 + 6) * 72 + kl] = (bf16_t)(w3 & 0xffffu); T[(n8 + 7) * 72 + kl] = (bf16_t)(w3 >> 16); }
        __syncthreads();
        { const int nl = tid >> 3, k8 = (tid & 7) * 8; const u32x4 v = *(const LAS u32x4*)(T + nl * 72 + k8); *(u32x4*)(jdst + (size_t)(n0 + nl) * jK + k0 + k8) = v; }
        __syncthreads();
    }
}
DI void convert_set1(const Params& p, LAS unsigned char* lds) {
    bf16_t* W1 = (bf16_t*)(p.ws + OFF_W1);
    for (int l = 0; l < 2; ++l) { bf16_t* wl = W1 + l * W1_LAYER;
        convert_job(p.ret_w_in + (size_t)l * 1024 * 6144, nullptr, p.norm_mix_g + l * 1024, wl, 1024, 6144, 6144, 1, 1.0f, lds, (int)blockIdx.x, (int)gridDim.x);
        convert_job(p.ret_w_o + (size_t)l * 2048 * 1024, nullptr, nullptr, wl + W1_WO, 2048, 1024, 1024, 0, 1.0f, lds, (int)blockIdx.x, (int)gridDim.x);
        convert_job(p.ffn_w1 + (size_t)l * 1024 * FFH, p.ffn_w3 + (size_t)l * 1024 * FFH, p.norm_ffn_g + l * 1024, wl + W1_WUP, 1024, FFH, 5632, 2, 1.0f, lds, (int)blockIdx.x, (int)gridDim.x);
        convert_job(p.ffn_w2 + (size_t)l * FFH * 1024, nullptr, nullptr, wl + W1_WDN, FFH, 1024, 1024, 0, 1.0f, lds, (int)blockIdx.x, (int)gridDim.x); }
}
DI void convert_set2(const Params& p, LAS unsigned char* lds, const int first, const int stride) {
    bf16_t* W2 = (bf16_t*)(p.ws + OFF_W2);
    convert_job(p.mla_w_kv_a, nullptr, p.mla_norm_kv_g, W2, 1024, 576, 768, 3, 1.0f, lds, first, stride);
    convert_job(p.mla_w_kv_b, nullptr, p.mla_kv_a_norm_g, W2 + W2_KVB, 512, 2048, 2048, 0, 1.0f, lds, first, stride);
    for (int jj = 0; jj < 2; ++jj) { bf16_t* wl = W2 + W2_L0 + jj * W2_LAYER; const int l = 2 + jj;
        convert_job(p.mla_w_q_a + (size_t)jj * 1024 * 768, nullptr, p.norm_mix_g + l * 1024, wl, 1024, 768, 768, 0, 1.0f, lds, first, stride);
        convert_job(p.mla_w_q_b + (size_t)jj * 768 * 1536, nullptr, p.mla_q_a_norm_g + jj * 768, wl + W2_WQB, 768, 1536, 1536, 4, 0.07216878364870322f * 1.4426950408889634f, lds, first, stride);
        convert_job(p.mla_w_o + (size_t)jj * 1024 * 1024, nullptr, nullptr, wl + W2_WOM, 1024, 1024, 1024, 0, 1.0f, lds, first, stride);
        convert_job(p.ffn_w1 + (size_t)l * 1024 * FFH, p.ffn_w3 + (size_t)l * 1024 * FFH, p.norm_ffn_g + l * 1024, wl + W2_WUP, 1024, FFH, 5632, 2, 1.0f, lds, first, stride);
        convert_job(p.ffn_w2 + (size_t)l * FFH * 1024, nullptr, nullptr, wl + W2_WDN, FFH, 1024, 1024, 0, 1.0f, lds, first, stride); }
}

DI void prologue_rows(const Params& p) {
    const int tid = otid(), lane = tid & 63, gw = blockIdx.x * 8 + (tid >> 6), nw = gridDim.x * 8;
    bf16_t* HB = (bf16_t*)(p.ws + OFF_HB); float* SSQ = (float*)(p.ws + OFF_SSQ);
    for (int row0 = gw; row0 < MR; row0 += 2 * nw) {
        f32x4 v[2][4]; int rows[2];
#pragma unroll
        for (int u = 0; u < 2; ++u) { const int rw = row0 + u * nw, row = rw < MR ? rw : row0; rows[u] = row; const float* src = p.x + ((size_t)row << 10);
#pragma unroll
            for (int c = 0; c < 4; ++c) v[u][c] = *(const f32x4*)(src + c * 256 + lane * 4); }
#pragma unroll
        for (int u = 0; u < 2; ++u) { if (u == 1 && row0 + nw >= MR) break; const int row = rows[u]; float ss = 0.f;
#pragma unroll
            for (int c = 0; c < 4; ++c) { const int col = c * 256 + lane * 4; const f32x4 w4 = v[u][c];
                ss += (w4[0] * w4[0] + w4[1] * w4[1]) + (w4[2] * w4[2] + w4[3] * w4[3]);
                u32x2 w; w.x = pk2(w4[0], w4[1]); w.y = pk2(w4[2], w4[3]); *(u32x2*)(HB + (size_t)row * DM + col) = w; }
            ss = wsum(ss);
            if (lane == 0) { SSQ[row] = ss; SSQ[MR + row] = 0.f; } } }
    const int gt = blockIdx.x * 512 + tid, nt = gridDim.x * 512;
    float* cosr = (float*)(p.ws + OFF_COSR); float* sinr = (float*)(p.ws + OFF_SINR); float* cosm = (float*)(p.ws + OFF_COSM); float* sinm = (float*)(p.ws + OFF_SINM);
    for (int idx = gt; idx < NPOS * 160; idx += nt) { const int i = idx / 160, f = idx - i * 160; const bool isr = f < 128; const int ff = isr ? f : f - 128;
        const float inv = 1.0f / exp2f((isr ? (float)ff * (1.0f / 128.0f) : (float)ff * (1.0f / 32.0f)) * 13.287712379549449f);
        const float ang = (float)i * inv; const double rev = (double)ang * 0.15915494309189535; const float fr = (float)(rev - __builtin_rint(rev));
        const float c = __builtin_amdgcn_cosf(fr), s = __builtin_amdgcn_sinf(fr);
        if (isr) { cosr[i * 128 + ff] = c; sinr[i * 128 + ff] = s; } else { cosm[i * 32 + ff] = c; sinm[i * 32 + ff] = s; } }
}

template <bool DUMMY> DI void ret_phase(LAS unsigned char* lds, bf16_t* PROJ, bf16_t* HBD, const float* S0l) {
    constexpr int QS = 528, KS = 576, SS = 144, OQ = 0, OK = 33792, OV = OK + 36864, OS = OV + 36864;
    const int tid = otid(), wave = tid >> 6, lane = tid & 63, r = lane & 31, h = lane >> 5, fr = lane & 15, fq = lane >> 4, g1 = (lane >> 4) & 1, q4 = (lane & 15) >> 2, p4 = lane & 3;
    for (int item = blockIdx.x; item < 256; item += gridDim.x) {
        const int b = item >> 3, hd = (item >> 1) & 3, half = item & 1;
        const float lg2 = log2f(1.0f - exp2f(-5.0f - (float)hd)), cdec = ex2(lg2 * 64.0f);
        const int cw = wave * 32;
        f32x16 S[8];
        int ls_ = lane; asm volatile("" : "+v"(ls_)); const float* s0p = S0l + (size_t)(hd * 256 + 4 * (ls_ >> 5)) * 512 + half * 256 + cw + (ls_ & 31);
#pragma unroll
        for (int t = 0; t < 8; ++t)
#pragma unroll
            for (int e = 0; e < 16; ++e) S[t][e] = s0p[(32 * t + (e & 3) + 8 * (e >> 2)) * 512];
        for (int c = 0; c < 32; ++c) {
            float lg = lg2; int lc_ = lane; asm volatile("" : "+v"(lg), "+v"(lc_));
            const int r = lc_ & 31, h = lc_ >> 5, fr = lc_ & 15, fq = lc_ >> 4, g1 = (lc_ >> 4) & 1, q4 = (lc_ & 15) >> 2, p4 = lc_ & 3;
            bf16_t* base = PROJ + ((size_t)b * LB + c * 64) * RIN;
            int toff = (tid >> 5) * RIN + (tid & 31) * 8, ooff = (lane >> 2) * RIN + 2048 + hd * 512 + half * 256 + cw + (lane & 3) * 8; asm volatile("" : "+v"(toff), "+v"(ooff));
#pragma unroll
            for (int i = 0; i < 4; ++i) { const int row = (tid >> 5) + 16 * i, seg = tid & 31; const bf16_t* s = base + toff + i * 16 * RIN;
                const u32x4 vq = *(const u32x4*)(s + hd * 256), vk = *(const u32x4*)(s + 1024 + hd * 256), vv = *(const u32x4*)(s + 2048 + hd * 512 + half * 256);
                *(LAS u32x4*)(lds + OQ + row * QS + seg * 16) = vq; *(LAS u32x4*)(lds + OK + row * KS + seg * 16) = vk; *(LAS u32x4*)(lds + OV + row * KS + seg * 16) = vv; }
            __syncthreads();
#pragma unroll
            for (int t2 = 0; t2 < 2; ++t2) { const int tt = wave * 2 + t2, i0 = (tt >> 2) * 16, j0 = (tt & 3) * 16; f32x4 a4 = {0.f, 0.f, 0.f, 0.f};
#pragma unroll
                for (int ks = 0; ks < 8; ++ks) { const bf16x8 ka = *(const LAS bf16x8*)(lds + OK + (j0 + fr) * KS + (32 * ks + 8 * fq) * 2), qb = *(const LAS bf16x8*)(lds + OQ + (i0 + fr) * QS + (32 * ks + 8 * fq) * 2);
                    a4 = MFMA16(ka, qb, a4); }
                const int ii = i0 + fr, jb = j0 + 4 * fq;
                float frq = (float)(fr - 4 * fq); asm volatile("" : "+v"(frq));
#pragma unroll
                for (int e = 0; e < 4; ++e) a4[e] *= ex2(lg * fabsf(frq + (float)(i0 - j0 - e)));
                u32x2 w; w.x = pk2(a4[0], a4[1]); w.y = pk2(a4[2], a4[3]); *(LAS u32x2*)(lds + OS + ii * SS + jb * 2) = w; }
            __syncthreads();
            bf16x8 vB[4];
#pragma unroll
            for (int ks = 0; ks < 4; ++ks) { const LAS unsigned char* a = lds + OV + (16 * ks + 8 * h + q4) * KS + (cw + 16 * g1 + 4 * p4) * 2; vB[ks] = cat8(vtr(a), vtr(a + 4 * KS)); }
            f32x16 o0, o1;
#pragma unroll
            for (int e = 0; e < 16; ++e) { o0[e] = 0.f; o1[e] = 0.f; }
#pragma unroll
            for (int t = 0; t < 8; ++t) {
                { const bf16x8 sb = pack_acc<0>(S[t]); const LAS unsigned char* qa = lds + OQ + r * QS + (32 * t + 4 * h) * 2;
                  const bf16x8 A0 = cat8u(*(const LAS u32x2*)qa, *(const LAS u32x2*)(qa + 16)), A1 = cat8u(*(const LAS u32x2*)(qa + 32 * QS), *(const LAS u32x2*)(qa + 32 * QS + 16));
                  o0 = MFMA32(A0, sb, o0); o1 = MFMA32(A1, sb, o1); }
                { const bf16x8 sb = pack_acc<8>(S[t]); const LAS unsigned char* qa = lds + OQ + r * QS + (32 * t + 16 + 4 * h) * 2;
                  const bf16x8 A0 = cat8u(*(const LAS u32x2*)qa, *(const LAS u32x2*)(qa + 16)), A1 = cat8u(*(const LAS u32x2*)(qa + 32 * QS), *(const LAS u32x2*)(qa + 32 * QS + 16));
                  o0 = MFMA32(A0, sb, o0); o1 = MFMA32(A1, sb, o1); }
                }
#pragma unroll
            for (int e = 0; e < 16; ++e) { float hf4 = (float)(4 * h); asm volatile("" : "+v"(hf4)); const float tk = hf4 + (float)((e & 3) + 8 * (e >> 2) + 1); o0[e] *= ex2(lg * tk); o1[e] *= ex2(lg * (tk + 32.f)); }
#pragma unroll
            for (int ks = 0; ks < 4; ++ks) { const LAS unsigned char* sa = lds + OS + r * SS + (16 * ks + 8 * h) * 2;
                o0 = MFMA32(*(const LAS bf16x8*)sa, vB[ks], o0); o1 = MFMA32(*(const LAS bf16x8*)(sa + 32 * SS), vB[ks], o1); }
            { LAS bf16_t* vs = (LAS bf16_t*)(lds + OV) + cw + r;
#pragma unroll
              for (int e = 0; e < 16; ++e) { const int tk = (e & 3) + 8 * (e >> 2) + 4 * h; vs[tk * (KS / 2)] = (bf16_t)(pk2(o0[e], 0.f) & 0xffffu); vs[(tk + 32) * (KS / 2)] = (bf16_t)(pk2(o1[e], 0.f) & 0xffffu); }
              bf16_t* od = base + ooff;
              const LAS unsigned char* os = lds + OV + (lane >> 2) * KS + (cw + (lane & 3) * 8) * 2;
#pragma unroll
              for (int ps = 0; ps < 4; ++ps) { const u32x4 v = *(const LAS u32x4*)(os + ps * 16 * KS);
                  if (DUMMY) *(u32x4*)(HBD + ((size_t)b * LB + c * 64 + (lane >> 2) + 16 * ps) * DM + ((hd * 512 + half * 256 + cw + (lane & 3) * 8) & 1023)) = v;
                  else *(u32x4*)(od + (size_t)ps * 16 * RIN) = v; } }
            __builtin_amdgcn_sched_barrier(0);
#pragma unroll
            for (int ks = 0; ks < 4; ++ks) { float hf4 = (float)(4 * h); asm volatile("" : "+v"(hf4)); u32x4 w = __builtin_bit_cast(u32x4, vB[ks]); const float t0 = (float)(63 - 16 * ks) - 2.0f * hf4;
                u32x4 o; o.x = pk2(bflo(w.x) * ex2(lg * t0), bfhi(w.x) * ex2(lg * (t0 - 1.f))); o.y = pk2(bflo(w.y) * ex2(lg * (t0 - 2.f)), bfhi(w.y) * ex2(lg * (t0 - 3.f)));
                o.z = pk2(bflo(w.z) * ex2(lg * (t0 - 4.f)), bfhi(w.z) * ex2(lg * (t0 - 5.f))); o.w = pk2(bflo(w.w) * ex2(lg * (t0 - 6.f)), bfhi(w.w) * ex2(lg * (t0 - 7.f)));
                vB[ks] = __builtin_bit_cast(bf16x8, o); }
            __builtin_amdgcn_sched_barrier(0);
#pragma unroll
            for (int t = 0; t < 8; ++t) { S[t] *= cdec;
#pragma unroll
                for (int ks = 0; ks < 4; ++ks) { const LAS unsigned char* a = lds + OK + (16 * ks + 8 * h + q4) * KS + (32 * t + 16 * g1 + 4 * p4) * 2;
                    S[t] = MFMA32(cat8(vtr(a), vtr(a + 4 * KS)), vB[ks], S[t]); }
                }
            __syncthreads();
        }
    }
}
DI void gn_phase(const Params& p, int layer, bf16_t* PROJ) {
    const int tid = otid(), lane = tid & 63, gw = blockIdx.x * 8 + (tid >> 6), nw = gridDim.x * 8;
    const float* gg = p.ret_gn_g + layer * 2048;
    for (int row0 = gw; row0 < MR; row0 += 2 * nw) {
        u32x4 vo4[2][4], vg4[2][4]; bf16_t* prs[2];
#pragma unroll
        for (int u = 0; u < 2; ++u) { const int rw = row0 + u * nw, row = rw < MR ? rw : row0; prs[u] = PROJ + (size_t)row * RIN + 2048 + lane * 8;
#pragma unroll
            for (int hd = 0; hd < 4; ++hd) { vo4[u][hd] = *(const u32x4*)(prs[u] + hd * 512); vg4[u][hd] = *(const u32x4*)(prs[u] + 2048 + hd * 512); } }
#pragma unroll
        for (int u = 0; u < 2; ++u) { if (u == 1 && row0 + nw >= MR) break; bf16_t* pr = prs[u];
#pragma unroll
            for (int hd = 0; hd < 4; ++hd) { const u32x4 vo = vo4[u][hd], vg = vg4[u][hd];
                float o[8] = {bflo(vo.x), bfhi(vo.x), bflo(vo.y), bfhi(vo.y), bflo(vo.z), bfhi(vo.z), bflo(vo.w), bfhi(vo.w)};
                float g[8] = {bflo(vg.x), bfhi(vg.x), bflo(vg.y), bfhi(vg.y), bflo(vg.z), bfhi(vg.z), bflo(vg.w), bfhi(vg.w)};
                float s = 0.f;
#pragma unroll
                for (int e = 0; e < 8; ++e) s += o[e];
                const float mu = wsum(s) * (1.0f / 512.0f); float q = 0.f;
#pragma unroll
                for (int e = 0; e < 8; ++e) { o[e] -= mu; q += o[e] * o[e]; }
                const float rstd = rsqrtf(wsum(q) * (1.0f / 512.0f) + GN_EPS);
                const f32x4 ga = *(const f32x4*)(gg + hd * 512 + lane * 8), gb = *(const f32x4*)(gg + hd * 512 + lane * 8 + 4);
                f32x4 ra, rb;
#pragma unroll
                for (int e = 0; e < 4; ++e) { ra[e] = silu_f(g[e]) * (o[e] * rstd * ga[e]); rb[e] = silu_f(g[4 + e]) * (o[4 + e] * rstd * gb[e]); }
                *(u32x4*)(pr + 2048 + hd * 512) = pk8(ra, rb); } } }
}

DI void attn_phase(LAS unsigned char* lds, const bf16_t* Qn, const bf16_t* Qr, const bf16_t* Kn, const bf16_t* Kr, const bf16_t* V, bf16_t* AO, const bf16_t* KnM, const bf16_t* KrM, const bf16_t* VM) {
    constexpr int KST = 400, VST = 320, OVB = 64 * KST, BUF = OVB + 64 * VST;
    const int tid = otid(), wave = __builtin_amdgcn_readfirstlane(tid >> 6), lane = tid & 63, r = lane & 31, h = lane >> 5, g1 = (lane >> 4) & 1, q4 = (lane & 15) >> 2, p4 = lane & 3;
    const int G = (int)gridDim.x, vcu = (G == 256) ? ((int)blockIdx.x & 7) * 32 + ((int)blockIdx.x >> 3) : (int)blockIdx.x;
    for (int item = vcu; item < 1024; item += G) {
        const int bh = item >> 2, mbr = item & 3;
        const int b = bh >> 3, hd = bh & 7; const size_t rb = (size_t)b * LB;
        const char* knBase = (const char*)(Kn + rb * DM + hd * 128); const char* vBase = (const char*)(V + rb * DM + hd * 128); const unsigned krDelta = (unsigned)((const char*)(Kr + rb * 64) - knBase);
        const char* knM = (const char*)(KnM + hd * 128); const char* vM = (const char*)(VM + hd * 128); const unsigned krDeltaM = (unsigned)((const char*)KrM - knM);
        for (int uu = 0; uu < 2; ++uu) { const int qb = uu == 0 ? mbr + 1 : 8 - mbr;
            const int ntiles = 4 * qb + 1, cwv = 4 * (qb - 1) + 1 + (wave >> 1), q0 = (qb - 1) * 256;
            const bool active = true;
            const size_t qrow = rb + q0 + wave * 32 + r;
            bf16x8 qf[12];
            if (active) {
#pragma unroll
                for (int ks = 0; ks < 8; ++ks) qf[ks] = *(const bf16x8*)(Qn + qrow * DM + hd * 128 + 16 * ks + 8 * h);
#pragma unroll
                for (int ks = 0; ks < 4; ++ks) qf[8 + ks] = *(const bf16x8*)(Qr + qrow * 512 + hd * 64 + 16 * ks + 8 * h);
            } else {
#pragma unroll
                for (int ks = 0; ks < 12; ++ks) qf[ks] = (bf16x8){0, 0, 0, 0, 0, 0, 0, 0};
            }
            float mrun = -1.0e30f, lrun = 0.f;
            f32x16 O[4];
#pragma unroll
            for (int t = 0; t < 4; ++t)
#pragma unroll
                for (int e = 0; e < 16; ++e) O[t][e] = 0.f;
#define ATT_DMA(j, bufi) do { LAS unsigned char* bb_ = lds + (bufi) * BUF; const bool m0_ = (j) == 0; const char* kb0_ = m0_ ? knM : knBase; const char* vb0_ = m0_ ? vM : vBase; \
                const unsigned jn_ = m0_ ? 0u : (unsigned)((j) - 1) * 131072u, jr_ = m0_ ? krDeltaM : (unsigned)((j) - 1) * 8192u + krDelta; int ln_ = lane; asm volatile("" : "+v"(ln_)); \
                _Pragma("unroll") for (int i_ = 0; i_ < 6; ++i_) { const int I_ = wave + 8 * i_; \
                    if (I_ < 25) { const int o_ = I_ * 1024 + ln_ * 16, row_ = o_ / KST, seg_ = (o_ - row_ * KST) >> 4; const bool isr_ = seg_ >= 16 && seg_ < 24; \
                        const unsigned vo_ = isr_ ? jr_ + (unsigned)(row_ * 128 + (seg_ - 16) * 16) : jn_ + (unsigned)(row_ * 2048 + (seg_ < 16 ? seg_ * 16 : 0)); \
                        __builtin_amdgcn_global_load_lds((const unsigned*)(kb0_ + (size_t)vo_), (LAS unsigned*)(bb_ + I_ * 1024), 16, 0, 0); } \
                    else if (I_ < 45) { const int o_ = (I_ - 25) * 1024 + ln_ * 16, row_ = o_ / VST, seg_ = (o_ - row_ * VST) >> 4; \
                        const unsigned vo_ = jn_ + (unsigned)(row_ * 2048 + (seg_ < 16 ? seg_ * 16 : 0)); \
                        __builtin_amdgcn_global_load_lds((const unsigned*)(vb0_ + (size_t)vo_), (LAS unsigned*)(bb_ + OVB + (I_ - 25) * 1024), 16, 0, 0); } } } while (0)
#define ATT_DMA_WAIT(ahead) do { if (!(ahead)) asm volatile("s_waitcnt vmcnt(0)" ::: "memory"); else if (wave < 5) asm volatile("s_waitcnt vmcnt(6)" ::: "memory"); else asm volatile("s_waitcnt vmcnt(5)" ::: "memory"); } while (0)
            ATT_DMA(0, 0); if (ntiles > 1) ATT_DMA(1, 1); ATT_DMA_WAIT(ntiles > 1);
            asm volatile("s_waitcnt lgkmcnt(0)" ::: "memory"); __builtin_amdgcn_s_barrier(); asm volatile("" ::: "memory");
            for (int j = 0; j < ntiles; ++j) {
                const bool more = (j + 2 < ntiles);
                if (more) ATT_DMA(j + 2, (j + 2) % 3);
                if (active && j <= cwv) {
                    const LAS unsigned char* kb = lds + (j % 3) * BUF; const LAS unsigned char* vb = kb + OVB;
                    f32x16 s0, s1;
#pragma unroll
                    for (int e = 0; e < 16; ++e) { s0[e] = 0.f; s1[e] = 0.f; }
                    const LAS unsigned char* ka = kb + r * KST + 16 * h;
#define ATT_LDK(dst, g) do { _Pragma("unroll") for (int i_ = 0; i_ < 2; ++i_) { dst[2 * i_] = *(const LAS bf16x8*)(ka + 32 * (2 * (g) + i_)); dst[2 * i_ + 1] = *(const LAS bf16x8*)(ka + 32 * KST + 32 * (2 * (g) + i_)); } } while (0)
#define ATT_MMK(src, g) do { s0 = MFMA32(src[0], qf[2 * (g)], s0); s1 = MFMA32(src[1], qf[2 * (g)], s1); __builtin_amdgcn_sched_barrier(0); s0 = MFMA32(src[2], qf[2 * (g) + 1], s0); s1 = MFMA32(src[3], qf[2 * (g) + 1], s1); } while (0)
#define ATT_SB __builtin_amdgcn_sched_barrier(0)
                    bf16x8 kA[4], kB[4];
                    ATT_LDK(kA, 0); ATT_LDK(kB, 1); ATT_SB;
                    ATT_MMK(kA, 0); ATT_SB; ATT_LDK(kA, 2); ATT_SB;
                    ATT_MMK(kB, 1); ATT_SB; ATT_LDK(kB, 3); ATT_SB;
                    ATT_MMK(kA, 2); ATT_SB; ATT_LDK(kA, 4); ATT_SB;
                    ATT_MMK(kB, 3); ATT_SB; ATT_LDK(kB, 5); ATT_SB;
                    ATT_MMK(kA, 4); ATT_SB;
                    ATT_MMK(kB, 5); ATT_SB;
                    const LAS unsigned char* va = vb + (4 * h + q4) * VST + (16 * g1 + 4 * p4) * 2;
#define ATT_TR(d, off) "ds_read_b64_tr_b16 %" #d ", %8 offset:" #off "\n\t"
#define ATT_LDV(dst, kk) do { u32x2 a0_, a1_, a2_, a3_, a4_, a5_, a6_, a7_; const unsigned vaddr_ = (unsigned)(size_t)(va + 16 * VST * (kk)); \
        asm volatile("ds_read_b64_tr_b16 %0, %8\n\tds_read_b64_tr_b16 %1, %8 offset:2560\n\tds_read_b64_tr_b16 %2, %8 offset:64\n\tds_read_b64_tr_b16 %3, %8 offset:2624\n\t" \
                     "ds_read_b64_tr_b16 %4, %8 offset:128\n\tds_read_b64_tr_b16 %5, %8 offset:2688\n\tds_read_b64_tr_b16 %6, %8 offset:192\n\tds_read_b64_tr_b16 %7, %8 offset:2752" \
                     : "=&v"(a0_), "=&v"(a1_), "=&v"(a2_), "=&v"(a3_), "=&v"(a4_), "=&v"(a5_), "=&v"(a6_), "=&v"(a7_) : "v"(vaddr_) : "memory"); \
        dst[0] = cat8u(a0_, a1_); dst[1] = cat8u(a2_, a3_); dst[2] = cat8u(a4_, a5_); dst[3] = cat8u(a6_, a7_); } while (0)
#define ATT_WV(dst) asm volatile("s_waitcnt lgkmcnt(0)" : "+v"(dst[0]), "+v"(dst[1]), "+v"(dst[2]), "+v"(dst[3]) :: "memory")
                    bf16x8 vA[4], vB[4];
                    ATT_LDV(vA, 0); ATT_SB;
                    if (j == 0) {
#pragma unroll
                        for (int e = 0; e < 16; ++e) { s0[e] = -1.0e30f; if (e < 8) s1[e] = -1.0e30f; } }
                    float mx = s0[0];
#pragma unroll
                    for (int e = 1; e < 16; ++e) mx = fmaxf(mx, s0[e]);
#pragma unroll
                    for (int e = 0; e < 16; ++e) mx = fmaxf(mx, s1[e]);
                    { const u32x2 sw_ = __builtin_amdgcn_permlane32_swap(__float_as_uint(mx), __float_as_uint(mx), false, false); mx = fmaxf(__uint_as_float(sw_.x), __uint_as_float(sw_.y)); }
                    float mnew = mrun, alpha = 1.0f;
                    const bool grow = !__all((int)(mx - mrun <= 8.0f));
                    if (grow) { mnew = fmaxf(mrun, mx); alpha = ex2(mrun - mnew); mrun = mnew; }
                    float rs = 0.f;
#pragma unroll
                    for (int e = 0; e < 16; ++e) { s0[e] = ex2(s0[e] - mnew); s1[e] = ex2(s1[e] - mnew); rs += s0[e] + s1[e]; }
                    { const u32x2 sw_ = __builtin_amdgcn_permlane32_swap(__float_as_uint(rs), __float_as_uint(rs), false, false); rs = __uint_as_float(sw_.x) + __uint_as_float(sw_.y); } lrun = lrun * alpha + rs;
                    if (grow) {
#pragma unroll
                        for (int t = 0; t < 4; ++t) O[t] *= alpha; }
                    const bf16x8 pb0 = pack_acc<0>(s0), pb1 = pack_acc<8>(s0), pb2 = pack_acc<0>(s1), pb3 = pack_acc<8>(s1);
#define ATT_MMV(src, pb) do { O[0] = MFMA32(src[0], pb, O[0]); O[1] = MFMA32(src[1], pb, O[1]); O[2] = MFMA32(src[2], pb, O[2]); O[3] = MFMA32(src[3], pb, O[3]); } while (0)
                    ATT_SB; ATT_WV(vA); ATT_LDV(vB, 1); ATT_SB;
                    ATT_MMV(vA, pb0); ATT_SB;
                    ATT_WV(vB); ATT_LDV(vA, 2); ATT_SB;
                    ATT_MMV(vB, pb1); ATT_SB;
                    ATT_WV(vA); ATT_LDV(vB, 3); ATT_SB;
                    ATT_MMV(vA, pb2); ATT_SB;
                    ATT_WV(vB); ATT_SB;
                    ATT_MMV(vB, pb3);
#undef ATT_WV
#undef ATT_TR
#undef ATT_LDK
#undef ATT_SB
#undef ATT_MMK
#undef ATT_LDV
#undef ATT_MMV
                }
                ATT_DMA_WAIT(more);
                asm volatile("s_waitcnt lgkmcnt(0)" ::: "memory"); __builtin_amdgcn_s_barrier(); asm volatile("" ::: "memory");
            }
#undef ATT_DMA
#undef ATT_DMA_WAIT
            if (active) { const float inv = 1.0f / lrun; bf16_t* od = AO + qrow * DM + hd * 128 + 4 * h;
#pragma unroll
                for (int t = 0; t < 4; ++t)
#pragma unroll
                    for (int g4 = 0; g4 < 4; ++g4) { u32x2 w; w.x = pk2(O[t][4 * g4] * inv, O[t][4 * g4 + 1] * inv); w.y = pk2(O[t][4 * g4 + 2] * inv, O[t][4 * g4 + 3] * inv);
                        *(u32x2*)(od + 32 * t + 8 * g4) = w; } }
        }
    }
}

DI void final_phase(const Params& p) {
    const int tid = otid(), lane = tid & 63, gw = blockIdx.x * 8 + (tid >> 6), nw = gridDim.x * 8;
    const float* SSQ = (const float*)(p.ws + OFF_SSQ);
    f32x4 g[4];
#pragma unroll
    for (int c = 0; c < 4; ++c) g[c] = *(const f32x4*)(p.final_g + c * 256 + lane * 4);
    for (int rf = gw; rf < NB * SEQ; rf += 2 * nw) {
        const int rf2 = rf + nw; const bool has2 = rf2 < NB * SEQ; const int rfb = has2 ? rf2 : rf;
        float* o0 = p.out + ((size_t)rf << 10); float* o1 = p.out + ((size_t)rfb << 10);
        f32x4 v0[4], v1[4];
#pragma unroll
        for (int c = 0; c < 4; ++c) { v0[c] = *(const f32x4*)(o0 + c * 256 + lane * 4); v1[c] = *(const f32x4*)(o1 + c * 256 + lane * 4); }
        const float r0 = rsqrtf(SSQ[rf] * (1.0f / 1024.0f) + RMS_EPS), r1 = rsqrtf(SSQ[rfb] * (1.0f / 1024.0f) + RMS_EPS);
#pragma unroll
        for (int c = 0; c < 4; ++c) *(f32x4*)(o0 + c * 256 + lane * 4) = v0[c] * r0 * g[c];
        if (has2) {
#pragma unroll
            for (int c = 0; c < 4; ++c) *(f32x4*)(o1 + c * 256 + lane * 4) = v1[c] * r1 * g[c]; } }
}

#define XB_TMO      128
#define XB_XCNT(j)  (256  + 64 * (j))
#define XB_XSUB(j)  (1280 + 64 * (j))
#define XB_XGEN(j)  (2304 + 64 * (j))
#define XB_TOP      3328
#define XB_TOPGEN   3392
#define XCD_BAR_WORDS 3456
#define XB_SPIN_CAP (1u << 22)

__device__ __forceinline__ unsigned xb_ld(unsigned* p)              { return __hip_atomic_load(p, __ATOMIC_RELAXED, __HIP_MEMORY_SCOPE_AGENT); }
__device__ __forceinline__ unsigned xb_add(unsigned* p, unsigned v) { return __hip_atomic_fetch_add(p, v, __ATOMIC_RELAXED, __HIP_MEMORY_SCOPE_AGENT); }
__device__ __forceinline__ unsigned xb_xcc_id() { return (unsigned)__builtin_amdgcn_s_getreg((3 << 11) | 20) & 0xFu; }
#define XB_SPIN(cond, bar) do { unsigned _sp = 0; while (cond) { __builtin_amdgcn_s_sleep(1); \
    if ((++_sp & 255u) == 0u) { if (xb_ld(&(bar)[XB_TMO])) break; if (_sp > XB_SPIN_CAP) { atomicAdd(&(bar)[XB_TMO], 1u); break; } } } } while (0)

struct XcdBarrier {
    unsigned* bar; unsigned x;
    volatile LAS unsigned* st;
};

__device__ __forceinline__ XcdBarrier xcd_barrier_post(unsigned* bar, volatile LAS unsigned* st) {
    XcdBarrier b; b.bar = bar; b.x = xb_xcc_id(); b.st = st;
    if (threadIdx.x == 0) (void)xb_add(&bar[XB_XCNT(b.x)], 1u);
    return b;
}
__device__ __forceinline__ void xcd_barrier_complete(unsigned* bar, unsigned x, unsigned& nloc, unsigned& nx) {
    const unsigned G = gridDim.x * gridDim.y * gridDim.z;
    unsigned sum, cnt, mine, sp = 0u;
    for (;;) {
        sum = 0u; cnt = 0u; mine = 0u;
#pragma unroll
        for (unsigned j = 0; j < 16; ++j) { const unsigned c = xb_ld(&bar[XB_XCNT(j)]); sum += c; cnt += (c > 0u) ? 1u : 0u; mine = (j == x) ? c : mine; }
        if (sum == G) break;
        __builtin_amdgcn_s_sleep(1);
        if ((++sp & 255u) == 0u) { if (xb_ld(&bar[XB_TMO])) break; if (sp > XB_SPIN_CAP) { atomicAdd(&bar[XB_TMO], 1u); break; } }
    }
    nloc = mine > 0u ? mine : 1u; nx = cnt > 0u ? cnt : 1u;
}

__device__ __forceinline__ void xcd_barrier(const XcdBarrier& b) {
    asm volatile("s_waitcnt vmcnt(0)" ::: "memory");
    __syncthreads();
    if (threadIdx.x == 0) {
        unsigned* bar = b.bar;
        __builtin_amdgcn_s_waitcnt(0);
        unsigned nloc = b.st[0], nx = b.st[1];
        if (nloc == 0u) { xcd_barrier_complete(bar, b.x, nloc, nx); b.st[0] = nloc; b.st[1] = nx; }
        const unsigned old = xb_add(&bar[XB_XSUB(b.x)], 1u);
        const unsigned gen = old / nloc;
        if (old + 1u == (gen + 1u) * nloc) {
            __builtin_amdgcn_fence(__ATOMIC_RELEASE, "agent");
            asm volatile("s_waitcnt vmcnt(0)" ::: "memory");
            const unsigned og = xb_add(&bar[XB_TOP], 1u);
            const unsigned tg = og / nx;
            if (og + 1u == (tg + 1u) * nx) xb_add(&bar[XB_TOPGEN], 1u);
            else XB_SPIN(xb_ld(&bar[XB_TOPGEN]) == tg, bar);
            __builtin_amdgcn_fence(__ATOMIC_ACQUIRE, "agent");
            xb_add(&bar[XB_XGEN(b.x)], 1u);
            asm volatile("s_waitcnt vmcnt(0)" ::: "memory");
        } else {
            XB_SPIN(xb_ld(&bar[XB_XGEN(b.x)]) == gen, bar);
            __builtin_amdgcn_fence(__ATOMIC_ACQUIRE, "agent");
            asm volatile("s_waitcnt vmcnt(0)" ::: "memory");
        }
    }
    __syncthreads();
}

DI void gbar(LAS unsigned char* lds);
DI float rb16(float v) { return __uint_as_float(pk2(v, 0.f) << 16); }
template <int K> DI void skinny(LAS unsigned char* lds, const bf16_t* Bt, const int N, float* C) {
    constexpr int NIT = (K + 511) / 512;
    const int tid = otid(), lane = tid & 63, gw = blockIdx.x * 8 + (tid >> 6), nw = gridDim.x * 8;
    for (int n = gw; n < N; n += nw) {
        float acc[16];
#pragma unroll
        for (int r = 0; r < 16; ++r) acc[r] = 0.f;
        u32x4 bw[NIT];
#pragma unroll
        for (int it = 0; it < NIT; ++it) { const int k0 = lane * 8 + 512 * it; bw[it] = (u32x4){0u, 0u, 0u, 0u}; if (k0 < K) bw[it] = *(const u32x4*)(Bt + (size_t)n * K + k0); }
#pragma unroll
        for (int it = 0; it < NIT; ++it) { const int k0 = lane * 8 + 512 * it;
            if (k0 < K) { const float b0 = bflo(bw[it].x), b1 = bfhi(bw[it].x), b2 = bflo(bw[it].y), b3 = bfhi(bw[it].y), b4 = bflo(bw[it].z), b5 = bfhi(bw[it].z), b6 = bflo(bw[it].w), b7 = bfhi(bw[it].w);
#pragma unroll
                for (int r = 0; r < 16; ++r) { const u32x4 aw = *(const LAS u32x4*)(lds + LDS_MA + (r * K + k0) * 2);
                    acc[r] += (bflo(aw.x) * b0 + bfhi(aw.x) * b1) + (bflo(aw.y) * b2 + bfhi(aw.y) * b3) + (bflo(aw.z) * b4 + bfhi(aw.z) * b5) + (bflo(aw.w) * b6 + bfhi(aw.w) * b7); } } }
#pragma unroll
        for (int k = 0; k < 8; ++k) { const bool hi = lane & 1; const float snd = hi ? acc[k] : acc[k + 8], kp = hi ? acc[k + 8] : acc[k]; acc[k] = kp + __shfl_xor(snd, 1); }
#pragma unroll
        for (int k = 0; k < 4; ++k) { const bool hi = lane & 2; const float snd = hi ? acc[k] : acc[k + 4], kp = hi ? acc[k + 4] : acc[k]; acc[k] = kp + __shfl_xor(snd, 2); }
#pragma unroll
        for (int k = 0; k < 2; ++k) { const bool hi = lane & 4; const float snd = hi ? acc[k] : acc[k + 2], kp = hi ? acc[k + 2] : acc[k]; acc[k] = kp + __shfl_xor(snd, 4); }
        { const bool hi = lane & 8; const float snd = hi ? acc[0] : acc[1], kp = hi ? acc[1] : acc[0]; acc[0] = kp + __shfl_xor(snd, 8); }
        float t = acc[0]; t += __shfl_xor(t, 16); t += __shfl_xor(t, 32);
        if (lane < 16) C[(8 * (lane & 1) + 4 * ((lane >> 1) & 1) + 2 * ((lane >> 2) & 1) + ((lane >> 3) & 1)) * N + n] = t;
    }
}
DI void meta_hm(LAS unsigned char* lds, const float* hsrc, const float* C, float* hdst) {
    const int tid = otid(), lane = tid & 63, wave = tid >> 6;
    LAS bf16_t* As = (LAS bf16_t*)(lds + LDS_MA); LAS float* RS = (LAS float*)(lds + LDS_MRS);
#pragma unroll
    for (int u = 0; u < 2; ++u) { const int r = 2 * wave + u; float ss = 0.f;
#pragma unroll
        for (int c = 0; c < 4; ++c) { const int col = c * 256 + lane * 4; f32x4 v = *(const f32x4*)(hsrc + r * 1024 + col); if (C) v += *(const f32x4*)(C + r * 1024 + col);
            if (hdst) *(f32x4*)(hdst + r * 1024 + col) = v;
            ss += (v[0] * v[0] + v[1] * v[1]) + (v[2] * v[2] + v[3] * v[3]);
            u32x2 w; w.x = pk2(v[0], v[1]); w.y = pk2(v[2], v[3]); *(LAS u32x2*)(As + r * 1024 + col) = w; }
        ss = wsum(ss); if (lane == 0) RS[r] = rsqrtf(ss * (1.0f / 1024.0f) + RMS_EPS); }
    __syncthreads();
}
DI void meta_front(const Params& p, LAS unsigned char* lds) {
    const int tid = otid(), lane = tid & 63, wave = tid >> 6, gt = blockIdx.x * 512 + tid, ntot = gridDim.x * 512;
    unsigned char* ws = p.ws;
    float* Cg0 = (float*)(ws + OFF_CM); float* Cg1 = Cg0 + 98304; float* Pm = (float*)(ws + OFF_PM); float* S0g = (float*)(ws + OFF_S0); float* HMg = (float*)(ws + OFF_HMG);
    const float* cosr = (const float*)(ws + OFF_COSR); const float* sinr = (const float*)(ws + OFF_SINR);
    const bf16_t* W1 = (const bf16_t*)(ws + OFF_W1);
    LAS bf16_t* As = (LAS bf16_t*)(lds + LDS_MA); LAS bf16_t* Ob = (LAS bf16_t*)(lds + LDS_MO); LAS float* RS = (LAS float*)(lds + LDS_MRS); float* SCg = (float*)(ws + OFF_SCG);
    int cur = 0;
    meta_hm(lds, p.meta, nullptr, HMg);
    for (int l = 0; l < 2; ++l) {
        const int tid = otid(), lane = tid & 63, wave = tid >> 6, gt = blockIdx.x * 512 + tid;
        const bf16_t* wl = W1 + l * W1_LAYER;
        { float* Cg = Cg0; skinny<1024>(lds, wl, RIN, Cg); gbar(lds);
        for (int idx = gt; idx < 16 * RIN; idx += ntot) { const int r = idx / RIN, n = idx - r * RIN; const float rs = RS[r]; float v = Cg[idx] * rs;
            if (n < 2048) { const int i = n & 127, n1 = n & ~128; const float x1 = Cg[r * RIN + n1] * rs, x2 = Cg[r * RIN + n1 + 128] * rs, c = cosr[r * 128 + i], sn = sinr[r * 128 + i];
                v = (n & 128) ? x1 * sn + x2 * c : x1 * c - x2 * sn; }
            Pm[idx] = rb16(v); }
        gbar(lds); }
        for (int idx = gt; idx < 4 * 256 * 512; idx += ntot) { const int hd = idx >> 17, d = (idx >> 9) & 255, c = idx & 511; const float lg2 = log2f(1.0f - exp2f(-5.0f - (float)hd)); float a = 0.f;
#pragma unroll 4
            for (int j = 0; j < 16; ++j) a += Pm[j * RIN + 1024 + hd * 256 + d] * rb16(Pm[j * RIN + 2048 + hd * 512 + c] * ex2(lg2 * (float)(15 - j)));
            S0g[(size_t)l * 524288 + idx] = a; }
        for (int t = blockIdx.x * 8 + wave; t < 1024; t += gridDim.x * 8) { const int hd = t >> 8, i = (t >> 4) & 15, j = t & 15; const float lg2 = log2f(1.0f - exp2f(-5.0f - (float)hd));
            const f32x4 qv = *(const f32x4*)(Pm + i * RIN + hd * 256 + lane * 4), kv = *(const f32x4*)(Pm + j * RIN + 1024 + hd * 256 + lane * 4);
            const float a = wsum((qv[0] * kv[0] + qv[1] * kv[1]) + (qv[2] * kv[2] + qv[3] * kv[3]));
            if (lane == 0) SCg[t] = rb16(a * ex2(lg2 * fabsf((float)(i - j)))); }
        gbar(lds);
        { LAS bf16_t* Vs = (LAS bf16_t*)(lds + LDS_MA); LAS float* SCs = (LAS float*)(lds + LDS_MA + 65536);
          for (int t = tid; t < 1024; t += 512) SCs[t] = SCg[t];
#pragma unroll 4
          for (int q = tid; q < 16 * 512; q += 512) { const int i = q >> 9, c4 = (q & 511) * 4; const f32x4 v = *(const f32x4*)(Pm + i * RIN + 2048 + c4);
              u32x2 w; w.x = pk2(v[0], v[1]); w.y = pk2(v[2], v[3]); *(LAS u32x2*)(Vs + i * 2048 + c4) = w; }
          __syncthreads();
          for (int idx = tid; idx < 16 * 2048; idx += 512) { const int i = idx >> 11, c = idx & 2047, hd = c >> 9; float a = 0.f;
#pragma unroll
              for (int j = 0; j < 16; ++j) a += SCs[hd * 256 + i * 16 + j] * __uint_as_float((unsigned)Vs[j * 2048 + c] << 16);
              Ob[idx] = (bf16_t)(pk2(a, 0.f) & 0xffffu); }
          __syncthreads(); }
        for (int task = wave; task < 64; task += 8) { const int i = task >> 2, hd = task & 3; const LAS bf16_t* po = Ob + i * 2048 + hd * 512 + lane * 8; float o[8]; float sm = 0.f;
#pragma unroll
            for (int e = 0; e < 8; ++e) { o[e] = __uint_as_float((unsigned)po[e] << 16); sm += o[e]; }
            const float mu = wsum(sm) * (1.0f / 512.0f); float q = 0.f;
#pragma unroll
            for (int e = 0; e < 8; ++e) { o[e] -= mu; q += o[e] * o[e]; }
            const float rstd = rsqrtf(wsum(q) * (1.0f / 512.0f) + GN_EPS);
#pragma unroll
            for (int e = 0; e < 8; ++e) { const int c = hd * 512 + lane * 8 + e; const float g = Pm[i * RIN + 4096 + c];
                As[i * 2048 + c] = (bf16_t)(pk2(silu_f(g) * (o[e] * rstd * p.ret_gn_g[l * 2048 + c]), 0.f) & 0xffffu); } }
        __syncthreads();
        skinny<2048>(lds, wl + W1_WO, 1024, Cg1); gbar(lds);
        meta_hm(lds, HMg + cur * 16384, Cg1, HMg + (cur ^ 1) * 16384); cur ^= 1;
        skinny<1024>(lds, wl + W1_WUP, 5632, Cg0); gbar(lds);
#pragma unroll 2
        for (int q = tid; q < 16 * (FFH / 4); q += 512) { const int r = q / (FFH / 4), c = (q - r * (FFH / 4)) * 4, g = c >> 7, j = c & 127; const float rs = RS[r];
            const f32x4 a = *(const f32x4*)(Cg0 + r * 5632 + (2 * g) * 128 + j) * rs, b = *(const f32x4*)(Cg0 + r * 5632 + (2 * g + 1) * 128 + j) * rs;
            u32x2 w; w.x = pk2(silu_f(a[0]) * b[0], silu_f(a[1]) * b[1]); w.y = pk2(silu_f(a[2]) * b[2], silu_f(a[3]) * b[3]); *(LAS u32x2*)(As + r * FFH + c) = w; }
        __syncthreads();
        skinny<FFH>(lds, wl + W1_WDN, 1024, Cg1); gbar(lds);
        meta_hm(lds, HMg + cur * 16384, Cg1, HMg + (cur ^ 1) * 16384); cur ^= 1;
    }
}
DI void meta_kv(const Params& p, LAS unsigned char* lds) {
    const int tid = otid(), lane = tid & 63, wave = tid >> 6;
    unsigned char* ws = p.ws;
    float* Cg0 = (float*)(ws + OFF_CM); float* Cg1 = Cg0 + 98304; const float* HMg = (const float*)(ws + OFF_HMG);
    const float* cosm = (const float*)(ws + OFF_COSM); const float* sinm = (const float*)(ws + OFF_SINM);
    const bf16_t* W2 = (const bf16_t*)(ws + OFF_W2);
    bf16_t* KnM = (bf16_t*)(ws + OFF_KNM); bf16_t* VM = (bf16_t*)(ws + OFF_VM); bf16_t* KrM = (bf16_t*)(ws + OFF_KRM);
    LAS bf16_t* As = (LAS bf16_t*)(lds + LDS_MA); LAS float* RS = (LAS float*)(lds + LDS_MRS);
    meta_hm(lds, HMg, nullptr, nullptr);
    skinny<1024>(lds, W2, 768, Cg0); gbar(lds);
#pragma unroll
    for (int u = 0; u < 2; ++u) { const int r = 2 * wave + u; const float rs = RS[r]; float v[8]; float ss = 0.f;
#pragma unroll
        for (int e = 0; e < 8; ++e) { v[e] = Cg0[r * 768 + lane * 8 + e] * rs; ss += v[e] * v[e]; }
        ss = wsum(ss);
#pragma unroll
        for (int e = 0; e < 8; ++e) As[r * 512 + lane * 8 + e] = (bf16_t)(pk2(v[e], 0.f) & 0xffffu);
        if (lane == 0) RS[16 + r] = rsqrtf(ss * (1.0f / 512.0f) + RMS_EPS);
        if (lane < 32) { const float x1 = Cg0[r * 768 + 512 + lane] * rs, x2 = Cg0[r * 768 + 640 + lane] * rs, c = cosm[r * 32 + lane], sn = sinm[r * 32 + lane];
            KrM[(48 + r) * 64 + lane] = (bf16_t)(pk2(x1 * c - x2 * sn, 0.f) & 0xffffu); KrM[(48 + r) * 64 + 32 + lane] = (bf16_t)(pk2(x1 * sn + x2 * c, 0.f) & 0xffffu); } }
    for (int idx = tid; idx < 48 * 1024; idx += 512) { KnM[idx] = 0; VM[idx] = 0; }
    for (int idx = tid; idx < 48 * 64; idx += 512) KrM[idx] = 0;
    __syncthreads();
    skinny<512>(lds, W2 + W2_KVB, 2048, Cg1); gbar(lds);
    for (int idx = tid; idx < 16 * 2048; idx += 512) { const int r = idx >> 11, n = idx & 2047, head = n >> 8, j = n & 255; const float v = Cg1[idx] * RS[16 + r];
        bf16_t* dst = (j < 128 ? KnM : VM) + (48 + r) * 1024 + head * 128 + (j & 127); *dst = (bf16_t)(pk2(v, 0.f) & 0xffffu); }
    __syncthreads();
}

typedef const __attribute__((address_space(4))) Params* KArgP;
DI Params ldp() {
#if defined(__HIP_DEVICE_COMPILE__)
    KArgP kp = (KArgP)__builtin_amdgcn_kernarg_segment_ptr(); asm volatile("" : "+s"(kp));
    Params r; const __attribute__((address_space(4))) unsigned long long* s = (const __attribute__((address_space(4))) unsigned long long*)kp; unsigned long long* d = (unsigned long long*)&r;
#pragma unroll
    for (int i = 0; i < (int)(sizeof(Params) / 8); ++i) d[i] = s[i];
    return r;
#else
    return Params{};
#endif
}
#ifndef PHM
#define PHM 0xffff
#endif
#ifndef PHD
#define PHD 0
#endif
#define WSP(T, off) ((T*)(ws + (off)))
DI void zero_rs(float* rs) { int st = (int)gridDim.x * 512; asm volatile("" : "+s"(st)); float z = 0.f; asm volatile("" : "+v"(z)); for (int i = (int)blockIdx.x * 512 + otid(); i < MR; i += st) rs[i] = z; }
DI void ph_win(LAS unsigned char* lds, int l) { const Params p = ldp(); unsigned char* ws = p.ws; zero_rs(WSP(float, OFF_SSQ) + MR);
    EpiWin E{WSP(bf16_t, OFF_PROJ), WSP(float, OFF_SSQ), WSP(float, OFF_COSR), WSP(float, OFF_SINR)}; run_gemm(lds, WSP(bf16_t, OFF_HB), DM, WSP(bf16_t, OFF_W1) + l * W1_LAYER, RIN, 1024, E); }
DI void ph_res(LAS unsigned char* lds, const bf16_t* A, int lda, const bf16_t* Bt, int K, bool first, bool mixer) { const Params p = ldp(); unsigned char* ws = p.ws;
    if (mixer) zero_rs(WSP(float, OFF_SSQ));
    EpiRes E{first ? p.x : p.out, p.out, WSP(float, OFF_HM), WSP(bf16_t, OFF_HB), WSP(float, OFF_SSQ) + (mixer ? MR : 0)}; run_gemm(lds, A, lda, Bt, 1024, K, E); }
DI void ph_up(LAS unsigned char* lds, const bf16_t* Bt) { const Params p = ldp(); unsigned char* ws = p.ws;
    EpiUp E{WSP(bf16_t, OFF_U), WSP(float, OFF_SSQ) + MR}; run_gemm(lds, WSP(bf16_t, OFF_HB), DM, Bt, 5632, 1024, E); }
DI void ph_null(LAS unsigned char* lds, const bf16_t* A, int lda, const bf16_t* Bt, int N, int K) { const Params p = ldp(); unsigned char* ws = p.ws;
    EpiNull E{WSP(float, OFF_SSQ2)}; run_gemm(lds, A, lda, Bt, N, K, E); }
DI void ph_kva(LAS unsigned char* lds) { const Params p = ldp(); unsigned char* ws = p.ws;
    EpiKva E{WSP(bf16_t, OFF_CKV), WSP(bf16_t, OFF_KR), WSP(float, OFF_SSQ), WSP(float, OFF_SSQ2), WSP(float, OFF_COSM), WSP(float, OFF_SINM)}; run_gemm(lds, WSP(bf16_t, OFF_HB), DM, WSP(bf16_t, OFF_W2), 768, 1024, E); }
DI void ph_qa(LAS unsigned char* lds, int jj) { const Params p = ldp(); unsigned char* ws = p.ws; zero_rs(WSP(float, OFF_SSQ) + MR);
    EpiQa E{WSP(bf16_t, OFF_CQ), WSP(float, OFF_SSQ), WSP(float, OFF_SSQ3)}; run_gemm(lds, WSP(bf16_t, OFF_HB), DM, WSP(bf16_t, OFF_W2) + W2_L0 + jj * W2_LAYER, 768, 1024, E); }
DI void ph_kvb(LAS unsigned char* lds) { const Params p = ldp(); unsigned char* ws = p.ws;
    EpiKvb E{WSP(bf16_t, OFF_KN), WSP(bf16_t, OFF_V), WSP(float, OFF_SSQ2)}; run_gemm(lds, WSP(bf16_t, OFF_CKV), 512, WSP(bf16_t, OFF_W2) + W2_KVB, 2048, 512, E); }
DI void ph_qb(LAS unsigned char* lds, int jj) { const Params p = ldp(); unsigned char* ws = p.ws;
    EpiQb E{WSP(bf16_t, OFF_QN), WSP(bf16_t, OFF_QR), WSP(float, OFF_SSQ3), WSP(float, OFF_COSM), WSP(float, OFF_SINM)}; run_gemm(lds, WSP(bf16_t, OFF_CQ), 768, WSP(bf16_t, OFF_W2) + W2_L0 + jj * W2_LAYER + W2_WQB, 1536, 768, E); }
DI void ph_attn(LAS unsigned char* lds) { const Params p = ldp(); unsigned char* ws = p.ws;
    attn_phase(lds, WSP(bf16_t, OFF_QN), WSP(bf16_t, OFF_QR), WSP(bf16_t, OFF_KN), WSP(bf16_t, OFF_KR), WSP(bf16_t, OFF_V), WSP(bf16_t, OFF_AO), WSP(bf16_t, OFF_KNM), WSP(bf16_t, OFF_KRM), WSP(bf16_t, OFF_VM)); }

DI void gbar(LAS unsigned char* lds) { const Params p = ldp(); XcdBarrier b; b.bar = (unsigned*)(p.ws + OFF_BAR); b.x = xb_xcc_id(); b.st = (volatile LAS unsigned*)(lds + LDS_XB); xcd_barrier(b); }

__global__ void __launch_bounds__(512, 2) yoco_fwd(Params p_unused) {
    extern __shared__ __attribute__((aligned(16))) unsigned char shm[];
    LAS unsigned char* lds = (LAS unsigned char*)shm;
    cg::grid_group grid = cg::this_grid();
    if (threadIdx.x < 4) ((volatile LAS unsigned*)(lds + LDS_XB))[threadIdx.x] = 0u;
    __syncthreads();
    { const Params p = ldp(); (void)xcd_barrier_post((unsigned*)(p.ws + OFF_BAR), (volatile LAS unsigned*)(lds + LDS_XB)); }
    if (PHM & 1) { const Params p = ldp(); prologue_rows(p); }
    if (PHM & 2) { const Params p = ldp(); convert_set1(p, lds); }
    grid.sync();
    { const Params p = ldp(); meta_front(p, lds); }
    if (PHD & 131072) { const Params p = ldp(); meta_front(p, lds); }
    for (int l = 0; l < 2; ++l) {
        if (PHM & 4) ph_win(lds, l);
        if (PHD & 4) ph_win(lds, l);
        gbar(lds);
        if (PHM & 8) { const Params p = ldp(); ret_phase<false>(lds, (bf16_t*)(p.ws + OFF_PROJ), nullptr, (const float*)(p.ws + OFF_S0) + (size_t)l * 524288); }
        if (PHD & 8) { const Params p = ldp(); ret_phase<true>(lds, (bf16_t*)(p.ws + OFF_PROJ), (bf16_t*)(p.ws + OFF_HB), (const float*)(p.ws + OFF_S0) + (size_t)l * 524288); }
        gbar(lds);
        if (PHM & 16) { const Params p = ldp(); gn_phase(p, l, (bf16_t*)(p.ws + OFF_PROJ)); }
        gbar(lds);
        if (PHM & 32) { const Params p = ldp(); unsigned char* ws = p.ws; ph_res(lds, WSP(bf16_t, OFF_PROJ) + 4096, RIN, WSP(bf16_t, OFF_W1) + l * W1_LAYER + W1_WO, 2048, l == 0, true); }
        gbar(lds);
        if (PHM & 64) { const Params p = ldp(); unsigned char* ws = p.ws; ph_up(lds, WSP(bf16_t, OFF_W1) + l * W1_LAYER + W1_WUP); }
        if (PHD & 64) { const Params p = ldp(); unsigned char* ws = p.ws; ph_up(lds, WSP(bf16_t, OFF_W1) + l * W1_LAYER + W1_WUP); }
        if (PHD & 8192) { const Params p = ldp(); unsigned char* ws = p.ws; ph_null(lds, WSP(bf16_t, OFF_HB), DM, WSP(bf16_t, OFF_W1) + l * W1_LAYER + W1_WUP, 5632, 1024); }
        gbar(lds);
        if (PHD & 16384) { const Params p = ldp(); unsigned char* ws = p.ws; ph_null(lds, WSP(bf16_t, OFF_U), FFH, WSP(bf16_t, OFF_W1) + l * W1_LAYER + W1_WDN, 1024, FFH); }
        if (PHM & 32) { const Params p = ldp(); unsigned char* ws = p.ws; ph_res(lds, WSP(bf16_t, OFF_U), FFH, WSP(bf16_t, OFF_W1) + l * W1_LAYER + W1_WDN, FFH, false, false); }
        if ((PHM & 2) && l == 1) { const Params p = ldp(); const int nfive = 1056 - 4 * (int)gridDim.x; if (nfive <= 0 || nfive >= (int)gridDim.x) convert_set2(p, lds, (int)blockIdx.x, (int)gridDim.x); else if ((int)blockIdx.x >= nfive) convert_set2(p, lds, (int)blockIdx.x - nfive, (int)gridDim.x - nfive); }
        gbar(lds);
    }
    { const Params p = ldp(); meta_kv(p, lds); }
    for (int jj = 0; jj < 2; ++jj) {
        if ((PHM & 128) && jj == 0) ph_kva(lds);
        if (PHM & 256) ph_qa(lds, jj);
        gbar(lds);
        if ((PHM & 512) && jj == 0) ph_kvb(lds);
        if (PHM & 1024) ph_qb(lds, jj);
        gbar(lds);
        if (PHM & 2048) ph_attn(lds);
        if (PHD & 2048) ph_attn(lds);
        gbar(lds);
        if (PHM & 32) { const Params p = ldp(); unsigned char* ws = p.ws; ph_res(lds, WSP(bf16_t, OFF_AO), DM, WSP(bf16_t, OFF_W2) + W2_L0 + jj * W2_LAYER + W2_WOM, 1024, false, true); }
        gbar(lds);
        if (PHM & 64) { const Params p = ldp(); unsigned char* ws = p.ws; ph_up(lds, WSP(bf16_t, OFF_W2) + W2_L0 + jj * W2_LAYER + W2_WUP); }
        if (PHD & 64) { const Params p = ldp(); unsigned char* ws = p.ws; ph_up(lds, WSP(bf16_t, OFF_W2) + W2_L0 + jj * W2_LAYER + W2_WUP); }
        if (PHD & 8192) { const Params p = ldp(); unsigned char* ws = p.ws; ph_null(lds, WSP(bf16_t, OFF_HB), DM, WSP(bf16_t, OFF_W2) + W2_L0 + jj * W2_LAYER + W2_WUP, 5632, 1024); }
        gbar(lds);
        if (PHD & 16384) { const Params p = ldp(); unsigned char* ws = p.ws; ph_null(lds, WSP(bf16_t, OFF_U), FFH, WSP(bf16_t, OFF_W2) + W2_L0 + jj * W2_LAYER + W2_WDN, 1024, FFH); }
        if (PHM & 32) { const Params p = ldp(); unsigned char* ws = p.ws; ph_res(lds, WSP(bf16_t, OFF_U), FFH, WSP(bf16_t, OFF_W2) + W2_L0 + jj * W2_LAYER + W2_WDN, FFH, false, false); }
        gbar(lds);
    }
    if (PHD & 32768) { for (int k = 0; k < 40; ++k) gbar(lds); }
    if (PHM & 4096) { const Params p = ldp(); final_phase(p); }
}

extern "C" void kernel_launch(void* const* d_in, const int* in_sizes, int n_in, void* d_out, int out_size, void* d_ws, size_t ws_size, hipStream_t stream) {
    static int grid = 0;
    if (grid == 0) {
        if (n_in != 19 || out_size != NB * SEQ * DM || ws_size < WS_END2) { fprintf(stderr, "kernel_launch: unexpected shapes (n_in %d out %d ws %zu)\n", n_in, out_size, ws_size); grid = -1; return; }
        int dev = 0, cus = 0, per_cu = 0;
        (void)hipGetDevice(&dev); (void)hipDeviceGetAttribute(&cus, hipDeviceAttributeMultiprocessorCount, dev);
        (void)hipFuncSetAttribute((const void*)yoco_fwd, hipFuncAttributeMaxDynamicSharedMemorySize, LDS_BYTES);
        (void)hipOccupancyMaxActiveBlocksPerMultiprocessor(&per_cu, (const void*)yoco_fwd, 512, LDS_BYTES);
        if (per_cu < 1) per_cu = 1;
        grid = cus * per_cu;
    }
    if (grid < 0) return;
    (void)hipMemsetAsync((unsigned char*)d_ws + OFF_BAR, 0, XCD_BAR_WORDS * 4, stream);
    Params p{};
    const float** f = (const float**)&p;
    for (int i = 0; i < 19; ++i) f[i] = (const float*)d_in[i];
    p.out = (float*)d_out; p.ws = (unsigned char*)d_ws;
    void* args[] = {&p};
    hipError_t e = hipLaunchCooperativeKernel((const void*)yoco_fwd, dim3(grid), dim3(512), args, LDS_BYTES, stream);
    if (e != hipSuccess) fprintf(stderr, "cooperative launch failed: %s (grid %d)\n", hipGetErrorString(e), grid);
}
```

```cpp
#include <hip/hip_runtime.h>
#include <hip/hip_cooperative_groups.h>
#include <cstdio>
namespace cg = cooperative_groups;

namespace pg8 {
#define PG8_LAS __attribute__((address_space(3)))
typedef unsigned short bf16_t;
typedef short bf16x8 __attribute__((ext_vector_type(8)));
typedef float f32x4 __attribute__((ext_vector_type(4)));
typedef unsigned u32x4 __attribute__((ext_vector_type(4)));
constexpr int BM = 256, BK = 64, HALF = 128, HTB = HALF * BK * 2  , STAGE_BYTES = 8 * HTB, NXCD = 8, WGM = 8;

__host__ __device__ __forceinline__ int lds_byte(int r, int c) { const int st = (r >> 4) * 2 + (c >> 5), rr = r & 15, cc = c & 31, ob = rr * 64 + cc * 2; return st * 1024 + (ob ^ (((ob >> 9) & 1) << 5)); }
__host__ __device__ __forceinline__ void stage_rc(int b, int& R, int& C) { const int st = b / 1024, sb = b % 1024, swz = sb ^ (((sb >> 9) & 1) << 5); R = (st >> 1) * 16 + swz / 64; C = (st & 1) * 32 + (swz % 64) / 2; }
__host__ __device__ __forceinline__ int perm32(int rho) { const int n = rho >> 4, i = rho & 15; return 8 * (i >> 2) + 4 * n + (i & 3); }
struct Unit { int pm, pn; };
struct Gemm { const bf16_t* A; const bf16_t* Bt; int M, N, K, lda; };
struct StaticOrder {
    int nM, nN, nwg, G, c;
    __host__ __device__ void init(int M, int N, int G_, int c_) { nM = M / BM; nN = N / BM; nwg = nM * nN; G = G_; c = c_; }
    __host__ __device__ bool next(int i, Unit& u) const {
        const int L = i * G + c; if (L >= nwg) return false;
        int wgid = L; { const int q = nwg / NXCD, r = nwg % NXCD, xcd = wgid % NXCD, off = wgid / NXCD; wgid = (xcd < r ? xcd * (q + 1) : r * (q + 1) + (xcd - r) * q) + off; }
        const int nig = WGM * nN, gid = wgid / nig, fm = gid * WGM, gsz = (nM - fm) < WGM ? (nM - fm) : WGM;
        u.pm = fm + ((wgid % nig) % gsz); u.pn = (wgid % nig) / gsz; return true;
    }
    __device__ __forceinline__ void a_ready(const Unit&) const {}
    __device__ __forceinline__ void done(const Unit&) const {}
};
template <class Epi, class Sched>
__device__ __forceinline__ void gemm_phase(PG8_LAS unsigned char* lds, const Gemm g, const Sched& S, const Epi& E) {
    int tid_ = threadIdx.x; asm volatile("" : "+v"(tid_));
    const int tid = tid_, wid = __builtin_amdgcn_readfirstlane(tid >> 6), lane = tid & 63, wr = wid >> 2, wc = wid & 3, fr = lane & 15, fq = lane >> 4;
    const int K = g.K, nt = K / BK;
    unsigned voffA[2], voffB[2];
#pragma unroll
    for (int i = 0; i < 2; ++i) { int R, C; stage_rc(tid * 16 + i * 8192, R, C); const int Rb = Epi::PERM ? ((R & ~31) + perm32(R & 31)) : R;
        voffA[i] = (unsigned)(R * g.lda + C) * 2u; voffB[i] = (unsigned)(Rb * K + C) * 2u; }
    const size_t kstep = (size_t)(BK * 2);
    const size_t hstepA = (size_t)HALF * g.lda * 2, hstepB = (size_t)HALF * K * 2;
    const size_t tstepA = 2 * hstepA, tstepB = 2 * hstepB;
    const unsigned ldsw = (unsigned)wid * 1024u;
    const int aoff = lds_byte(wr * 64 + fr, fq * 8), boff = lds_byte(wc * 32 + fr, fq * 8);
#define PG8_SA(b, h) (((b) * 2 + (h)) * HTB)
#define PG8_SB(b, h) ((4 + (b) * 2 + (h)) * HTB)
#define PG8_STAGE(bufoff, gbase, voff) do { _Pragma("unroll") for (int _i = 0; _i < 2; ++_i) \
        __builtin_amdgcn_global_load_lds((const unsigned*)((const char*)(gbase) + (voff)[_i]), (PG8_LAS unsigned*)(lds + (bufoff) + ldsw + _i * 8192), 16, 0, 0); } while (0)
#define PG8_LDA(dst, b, h) do { _Pragma("unroll") for (int m = 0; m < 4; ++m) _Pragma("unroll") for (int k = 0; k < 2; ++k) dst[m][k] = *(const PG8_LAS bf16x8*)(lds + PG8_SA(b, h) + aoff + m * 2048 + k * 1024); } while (0)
#define PG8_LDB(dst, b, h) do { _Pragma("unroll") for (int n = 0; n < 2; ++n) _Pragma("unroll") for (int k = 0; k < 2; ++k) dst[n][k] = *(const PG8_LAS bf16x8*)(lds + PG8_SB(b, h) + boff + n * 2048 + k * 1024); } while (0)
#define PG8_MMA(ai, bj, At, Bt) do { __builtin_amdgcn_s_setprio(1); _Pragma("unroll") for (int m = 0; m < 4; ++m) _Pragma("unroll") for (int n = 0; n < 2; ++n) _Pragma("unroll") for (int k = 0; k < 2; ++k) \
        acc[ai][bj][m][n] = __builtin_amdgcn_mfma_f32_16x16x32_bf16(Bt[n][k], At[m][k], acc[ai][bj][m][n], 0, 0, 0); __builtin_amdgcn_s_setprio(0); } while (0)
#define PG8_WAIT_V(n) asm volatile("s_waitcnt vmcnt(" #n ")" ::: "memory")
#define PG8_WAIT_L(n) asm volatile("s_waitcnt lgkmcnt(" #n ")" ::: "memory")
#define PG8_BAR __builtin_amdgcn_s_barrier()
#define PG8_SCHED __builtin_amdgcn_sched_barrier(0)
    Unit cur, nxt; int ui = 0;
    typename Epi::Pre pre;
    if (!S.next(0, cur)) return;
    f32x4 acc[2][2][4][2];
#pragma unroll
    for (int a = 0; a < 2; ++a)
#pragma unroll
        for (int b = 0; b < 2; ++b)
#pragma unroll
            for (int m = 0; m < 4; ++m)
#pragma unroll
                for (int n = 0; n < 2; ++n) acc[a][b][m][n] = (f32x4){0.f, 0.f, 0.f, 0.f};
    bf16x8 At[4][2], B0[2][2], B1[2][2];
    const char* cA = (const char*)g.A + (size_t)cur.pm * tstepA; const char* cB = (const char*)g.Bt + (size_t)cur.pn * tstepB;
    S.a_ready(cur);
    PG8_STAGE(PG8_SB(0, 0), cB, voffB); PG8_STAGE(PG8_SA(0, 0), cA, voffA); PG8_STAGE(PG8_SB(0, 1), cB + hstepB, voffB); PG8_STAGE(PG8_SA(0, 1), cA + hstepA, voffA);
    if (wr == 1) PG8_BAR;
    PG8_WAIT_V(4); PG8_BAR;
    PG8_STAGE(PG8_SB(1, 0), cB + kstep, voffB); PG8_STAGE(PG8_SA(1, 0), cA + kstep, voffA); PG8_STAGE(PG8_SB(1, 1), cB + hstepB + kstep, voffB);
    PG8_WAIT_V(6); PG8_BAR;
    for (;;) {
        const bool has_next = S.next(ui + 1, nxt);
        const char* nA = has_next ? (const char*)g.A + (size_t)nxt.pm * tstepA : cA; const char* nB = has_next ? (const char*)g.Bt + (size_t)nxt.pn * tstepB : cB;
        for (int t = 0; t < nt; t += 2) {
            const bool last = (t == nt - 2);
            const char* a1 = cA + (size_t)(t + 1) * kstep;
            const char* a2 = last ? nA : cA + (size_t)(t + 2) * kstep; const char* b2 = last ? nB : cB + (size_t)(t + 2) * kstep;
            const char* a3 = a2 + kstep; const char* b3 = b2 + kstep;
            if (last && has_next) S.a_ready(nxt);
            if (last) E.prefetch(pre, cur, wr, fr, fq);
            PG8_LDB(B0, 0, 0); PG8_SCHED; PG8_LDA(At, 0, 0); PG8_STAGE(PG8_SA(1, 1), a1 + hstepA, voffA);
            PG8_WAIT_L(8); PG8_BAR; PG8_WAIT_L(0); PG8_MMA(0, 0, At, B0); PG8_BAR; PG8_SCHED;
            PG8_LDB(B1, 0, 1); PG8_STAGE(PG8_SB(0, 0), b2, voffB);
            PG8_BAR; PG8_WAIT_L(0); PG8_MMA(0, 1, At, B1); PG8_BAR;
            PG8_LDA(At, 0, 1); PG8_STAGE(PG8_SA(0, 0), a2, voffA);
            PG8_BAR; PG8_WAIT_L(0); PG8_MMA(1, 0, At, B0); PG8_BAR; PG8_SCHED;
            PG8_STAGE(PG8_SB(0, 1), b2 + hstepB, voffB);
            PG8_WAIT_V(6); PG8_BAR; PG8_MMA(1, 1, At, B1); PG8_BAR;
            PG8_LDB(B0, 1, 0); PG8_SCHED; PG8_LDA(At, 1, 0); PG8_STAGE(PG8_SA(0, 1), a2 + hstepA, voffA);
            PG8_WAIT_L(8); PG8_BAR; PG8_WAIT_L(0); PG8_MMA(0, 0, At, B0); PG8_BAR; PG8_SCHED;
            PG8_LDB(B1, 1, 1); PG8_STAGE(PG8_SB(1, 0), b3, voffB);
            PG8_BAR; PG8_WAIT_L(0); PG8_MMA(0, 1, At, B1); PG8_BAR;
            PG8_LDA(At, 1, 1); PG8_STAGE(PG8_SA(1, 0), a3, voffA);
            PG8_BAR; PG8_WAIT_L(0); PG8_MMA(1, 0, At, B0); PG8_BAR; PG8_SCHED;
            PG8_STAGE(PG8_SB(1, 1), b3 + hstepB, voffB);
            PG8_WAIT_V(6); PG8_BAR; PG8_MMA(1, 1, At, B1); PG8_BAR;
        }
        if constexpr (!Epi::AFTER_DRAIN) { E(acc, pre, cur, wr, wc, fr, fq); S.done(cur); }
        if (!has_next) break;
#pragma unroll
        for (int a = 0; a < 2; ++a)
#pragma unroll
            for (int b = 0; b < 2; ++b)
#pragma unroll
                for (int m = 0; m < 4; ++m)
#pragma unroll
                    for (int n = 0; n < 2; ++n) acc[a][b][m][n] = (f32x4){0.f, 0.f, 0.f, 0.f};
        cur = nxt; cA = nA; cB = nB; ++ui;
    }
    PG8_WAIT_V(0);
    if (wr == 0) PG8_BAR;
    PG8_BAR;
#undef PG8_SA
#undef PG8_SB
#undef PG8_STAGE
#undef PG8_LDA
#undef PG8_LDB
#undef PG8_MMA
#undef PG8_WAIT_V
#undef PG8_WAIT_L
#undef PG8_BAR
#undef PG8_SCHED
}
}

using pg8::bf16_t; using pg8::bf16x8; using pg8::f32x4; using pg8::u32x4;
typedef float f32x16 __attribute__((ext_vector_type(16)));
typedef float f32x2 __attribute__((ext_vector_type(2)));
typedef short s16x4 __attribute__((ext_vector_type(4)));
typedef unsigned u32x2 __attribute__((ext_vector_type(2)));
typedef __bf16 bf2_t __attribute__((ext_vector_type(2)));
typedef short v4i16_t __attribute__((ext_vector_type(4)));
#define LAS __attribute__((address_space(3)))
#define DI __device__ __forceinline__

constexpr int NB = 32, SEQ = 2048, DM = 1024, LB = 2048  , MR = NB * LB  , NPOS = 2064, FFH = 2816, RIN = 6144;
constexpr float RMS_EPS = 1e-6f, GN_EPS = 1e-5f;
constexpr size_t OFF_PROJ = 0;
constexpr size_t OFF_U = 0, OFF_CQ = 0, OFF_CKV = 103809024ull, OFF_AO = 0, OFF_QN = 173015040ull, OFF_QR = 311427072ull;
constexpr size_t OFF_KN = 380633088ull, OFF_V = 519045120ull, OFF_KR = 657457152ull, OFF_W2 = 666107904ull;
constexpr size_t OFF_HB = 830472192ull, OFF_W1 = 968884224ull, OFF_HM = 1037041664ull, OFF_SSQ = 1045430272ull, OFF_SSQ2 = 1049755648ull, OFF_SSQ3 = 1051918336ull;
constexpr size_t OFF_COSR = 1056243712ull, OFF_SINR = 1057325056ull, OFF_COSM = 1058406400ull, OFF_SINM = 1058676736ull, WS_END = 1058947072ull;
constexpr size_t W1_LAYER = 17039360ull, W1_WO = 6291456ull, W1_WUP = 8388608ull, W1_WDN = 14155776ull;
constexpr size_t W2_KVB = 786432ull, W2_L0 = 1835008ull, W2_LAYER = 11665408ull, W2_WQB = 786432ull, W2_WOM = 1966080ull, W2_WUP = 3014656ull, W2_WDN = 8781824ull;
constexpr int LDS_MA = 0, LDS_MO = 90112, LDS_MRS = 155648;
constexpr int LDS_XB = 155904;
constexpr int LDS_BYTES = LDS_XB + 16;
constexpr size_t OFF_BAR = WS_END, OFF_S0 = WS_END + 16384  , OFF_CM = OFF_S0 + 4194304  , OFF_PM = OFF_CM + 786432, OFF_HMG = OFF_PM + 393216  ,
    OFF_KNM = OFF_HMG + 131072  , OFF_VM = OFF_KNM + 131072, OFF_KRM = OFF_VM + 131072  , OFF_SCG = OFF_KRM + 8192  , WS_END2 = OFF_SCG + 4096;

struct Params {
    const float *x, *meta, *norm_mix_g, *norm_ffn_g, *ret_w_in, *ret_gn_g, *ret_w_o, *mla_norm_kv_g, *mla_w_kv_a, *mla_kv_a_norm_g, *mla_w_kv_b,
        *mla_w_q_a, *mla_q_a_norm_g, *mla_w_q_b, *mla_w_o, *ffn_w1, *ffn_w3, *ffn_w2, *final_g;
    float* out; unsigned char* ws;
};

DI unsigned pk2(float a, float b) { f32x2 v = {a, b}; bf2_t r = __builtin_convertvector(v, bf2_t); return __builtin_bit_cast(unsigned, r); }
DI u32x4 pk8(f32x4 a, f32x4 b) { u32x4 w; w.x = pk2(a[0], a[1]); w.y = pk2(a[2], a[3]); w.z = pk2(b[0], b[1]); w.w = pk2(b[2], b[3]); return w; }
DI float bflo(unsigned w) { return __uint_as_float(w << 16); }
DI float bfhi(unsigned w) { return __uint_as_float(w & 0xffff0000u); }
DI float ex2(float x) { return __builtin_amdgcn_exp2f(x); }
DI float wsum(float v) { v += __shfl_xor(v, 1); v += __shfl_xor(v, 2); v += __shfl_xor(v, 4); v += __shfl_xor(v, 8); v += __shfl_xor(v, 16); v += __shfl_xor(v, 32); return v; }
DI float sum4(const float* p, int n4) { float s = 0.f; for (int i = 0; i < n4; ++i) { const f32x4 a = *(const f32x4*)(p + 4 * i); s += (a[0] + a[1]) + (a[2] + a[3]); } return s; }
DI float silu_f(float a) { return a * __builtin_amdgcn_rcpf(1.0f + ex2(-1.4426950408889634f * a)); }
DI s16x4 vtr(const LAS unsigned char* p) { return __builtin_bit_cast(s16x4, __builtin_amdgcn_ds_read_tr16_b64_v4i16((LAS v4i16_t*)p)); }
DI bf16x8 cat8(s16x4 lo, s16x4 hi) { return __builtin_shufflevector(lo, hi, 0, 1, 2, 3, 4, 5, 6, 7); }
DI bf16x8 cat8u(u32x2 lo, u32x2 hi) { u32x4 w; w.x = lo.x; w.y = lo.y; w.z = hi.x; w.w = hi.y; return __builtin_bit_cast(bf16x8, w); }
#define MFMA32(a, b, c) __builtin_amdgcn_mfma_f32_32x32x16_bf16((a), (b), (c), 0, 0, 0)
#define MFMA16(a, b, c) __builtin_amdgcn_mfma_f32_16x16x32_bf16((a), (b), (c), 0, 0, 0)
template <int S8> DI bf16x8 pack_acc(const f32x16& x) { u32x4 w; w.x = pk2(x[S8 + 0], x[S8 + 1]); w.y = pk2(x[S8 + 2], x[S8 + 3]); w.z = pk2(x[S8 + 4], x[S8 + 5]); w.w = pk2(x[S8 + 6], x[S8 + 7]); return __builtin_bit_cast(bf16x8, w); }

DI const float* hrow_c(const float* frames, const float*, int row) { return frames + ((size_t)row << 10); }
DI float* hrow_m(float* frames, float*, int row) { return frames + ((size_t)row << 10); }

#define EPI_FOR_ROWS _Pragma("unroll") for (int ai = 0; ai < 2; ++ai) _Pragma("unroll") for (int m = 0; m < 4; ++m)
#define EPI_ROW (u.pm * 256 + ai * 128 + wr * 64 + m * 16 + fr)
typedef const f32x4 (&AccRef)[2][2][4][2];
struct PreNone {};
struct PreRstd { float v[8]; };
DI void rstd_load(PreRstd& pre, const float* rs, int row0) {
#pragma unroll
    for (int k = 0; k < 8; ++k) pre.v[k] = rs[row0 + (k >> 2) * 128 + (k & 3) * 16];
}
DI void rstd_reduce(float (&r)[8], const PreRstd& pre, float invn) {
#pragma unroll
    for (int k = 0; k < 8; ++k) r[k] = rsqrtf(pre.v[k] * invn + RMS_EPS);
}
template <int NQ, int STR> DI void rstd_rows(float (&rs)[8], const float* ssq, int row0, int fq, float invn) {
    f32x4 pt[8];
    const int fql = (NQ == 4 || fq < NQ) ? fq : 0; const float keep = (NQ == 4 || fq < NQ) ? 1.0f : 0.0f;
#pragma unroll
    for (int k = 0; k < 8; ++k) { const int row = row0 + (k >> 2) * 128 + (k & 3) * 16; pt[k] = *(const f32x4*)(ssq + (size_t)row * STR + 4 * fql); }
#pragma unroll
    for (int k = 0; k < 8; ++k) { float s = ((pt[k][0] + pt[k][1]) + (pt[k][2] + pt[k][3])) * keep; s += __shfl_xor(s, 16); s += __shfl_xor(s, 32); rs[k] = rsqrtf(s * invn + RMS_EPS); }
}
DI void rope8(u32x4& lo, u32x4& hi, f32x4 x1a, f32x4 x1b, f32x4 x2a, f32x4 x2b, f32x4 c0, f32x4 c1, f32x4 s0, f32x4 s1) {
    lo = pk8(x1a * c0 - x2a * s0, x1b * c1 - x2b * s1); hi = pk8(x1a * s0 + x2a * c0, x1b * s1 + x2b * c1); }

struct EpiWin {
    static constexpr bool PERM = true, AFTER_DRAIN = false; typedef PreRstd Pre;
    bf16_t* P; const float* ssq; const float* cosr; const float* sinr;
    DI void prefetch(Pre& pre, const pg8::Unit& u, int wr, int fr, int fq) const { rstd_load(pre, ssq, u.pm * 256 + wr * 64 + fr); }
    DI void operator()(AccRef acc, const Pre& pre, const pg8::Unit& u, int wr, int wc, int fr, int fq) const {
        asm volatile("" : "+v"(fr), "+v"(fq));
        const int cb = wc * 32 + 8 * fq, row0 = u.pm * 256 + wr * 64 + fr;
        float rs[8]; rstd_reduce(rs, pre, 1.0f / 1024.0f);
        if (u.pn < 8) {
#pragma unroll
            for (int aim = 0; aim < 4; ++aim) { const int ai = aim >> 1, mb = (aim & 1) * 2; f32x4 c0[4], c1[4], s0[4], s1[4];
#pragma unroll
                for (int m = mb; m < mb + 2; ++m) { const int i = (EPI_ROW & 2047) + 16;     const float* cp = cosr + i * 128 + cb; const float* sp = sinr + i * 128 + cb;
                    c0[m] = *(const f32x4*)cp; c1[m] = *(const f32x4*)(cp + 4); s0[m] = *(const f32x4*)sp; s1[m] = *(const f32x4*)(sp + 4); }
#pragma unroll
                for (int m = mb; m < mb + 2; ++m) { const float r = rs[ai * 4 + m]; bf16_t* dst = P + (size_t)EPI_ROW * RIN + u.pn * 256 + cb; u32x4 lo, hi;
                    rope8(lo, hi, acc[ai][0][m][0] * r, acc[ai][0][m][1] * r, acc[ai][1][m][0] * r, acc[ai][1][m][1] * r, c0[m], c1[m], s0[m], s1[m]);
                    *(u32x4*)dst = lo; *(u32x4*)(dst + 128) = hi; } }
        } else {
            EPI_FOR_ROWS { const float r = rs[ai * 4 + m]; bf16_t* dst = P + (size_t)EPI_ROW * RIN + u.pn * 256 + cb;
                *(u32x4*)dst = pk8(acc[ai][0][m][0] * r, acc[ai][0][m][1] * r); *(u32x4*)(dst + 128) = pk8(acc[ai][1][m][0] * r, acc[ai][1][m][1] * r); } }
    }
};
struct EpiRes {
    static constexpr bool PERM = true, AFTER_DRAIN = false; typedef PreNone Pre;
    DI void prefetch(Pre&, const pg8::Unit&, int, int, int) const {}
    const float* src_fr; float* dst_fr; float* hm; bf16_t* HB; float* ssq;
    DI void operator()(AccRef acc, const Pre&, const pg8::Unit& u, int wr, int wc, int fr, int fq) const {
        asm volatile("" : "+v"(fr), "+v"(fq));
        const int cb = u.pn * 256 + wc * 32 + 8 * fq;
#pragma unroll
        for (int ai = 0; ai < 2; ++ai) { f32x4 hv[4][4];
#pragma unroll
            for (int m = 0; m < 4; ++m) { const float* s = hrow_c(src_fr, hm, EPI_ROW) + cb; hv[m][0] = *(const f32x4*)s; hv[m][1] = *(const f32x4*)(s + 4); hv[m][2] = *(const f32x4*)(s + 128); hv[m][3] = *(const f32x4*)(s + 132); }
#pragma unroll
            for (int m = 0; m < 4; ++m) { const int row = EPI_ROW; float* d = hrow_m(dst_fr, hm, row) + cb; float ss = 0.f;
#pragma unroll
                for (int bj = 0; bj < 2; ++bj) { const f32x4 h0 = hv[m][2 * bj] + acc[ai][bj][m][0], h1 = hv[m][2 * bj + 1] + acc[ai][bj][m][1];
                    *(f32x4*)(d + bj * 128) = h0; *(f32x4*)(d + bj * 128 + 4) = h1; *(u32x4*)(HB + (size_t)row * DM + cb + bj * 128) = pk8(h0, h1);
                    ss += (h0[0] * h0[0] + h0[1] * h0[1]) + (h0[2] * h0[2] + h0[3] * h0[3]) + (h1[0] * h1[0] + h1[1] * h1[1]) + (h1[2] * h1[2] + h1[3] * h1[3]); }
                ss += __shfl_xor(ss, 16); ss += __shfl_xor(ss, 32);
                if (fq == 0) unsafeAtomicAdd(ssq + row, ss); } }
    }
};
struct EpiUp {
    static constexpr bool PERM = true, AFTER_DRAIN = false; typedef PreRstd Pre;
    bf16_t* U; const float* ssq;
    DI void prefetch(Pre& pre, const pg8::Unit& u, int wr, int fr, int fq) const { rstd_load(pre, ssq, u.pm * 256 + wr * 64 + fr); }
    DI void operator()(AccRef acc, const Pre& pre, const pg8::Unit& u, int wr, int wc, int fr, int fq) const {
        asm volatile("" : "+v"(fr), "+v"(fq));
        const int cb = u.pn * 128 + wc * 32 + 8 * fq, row0 = u.pm * 256 + wr * 64 + fr;
        float rs[8]; rstd_reduce(rs, pre, 1.0f / 1024.0f);
        EPI_FOR_ROWS { const float r = rs[ai * 4 + m], k1 = -1.4426950408889634f * r, rr = r * r; f32x4 o0, o1;
            const f32x4 p0 = acc[ai][0][m][0] * acc[ai][1][m][0] * rr, p1 = acc[ai][0][m][1] * acc[ai][1][m][1] * rr, m0 = acc[ai][0][m][0] * k1, m1 = acc[ai][0][m][1] * k1;
#pragma unroll
            for (int e = 0; e < 4; ++e) { o0[e] = p0[e] * __builtin_amdgcn_rcpf(1.0f + ex2(m0[e])); o1[e] = p1[e] * __builtin_amdgcn_rcpf(1.0f + ex2(m1[e])); }
            *(u32x4*)(U + (size_t)EPI_ROW * FFH + cb) = pk8(o0, o1); }
    }
};
struct EpiKva {
    static constexpr bool PERM = true, AFTER_DRAIN = false; typedef PreRstd Pre;
    bf16_t* CKV; bf16_t* Kr; const float* ssq; float* ssq2; const float* cosm; const float* sinm;
    DI void prefetch(Pre& pre, const pg8::Unit& u, int wr, int fr, int fq) const { rstd_load(pre, ssq, u.pm * 256 + wr * 64 + fr); }
    DI void operator()(AccRef acc, const Pre& pre, const pg8::Unit& u, int wr, int wc, int fr, int fq) const {
        asm volatile("" : "+v"(fr), "+v"(fq));
        const int row0 = u.pm * 256 + wr * 64 + fr;
        float rs[8]; rstd_reduce(rs, pre, 1.0f / 1024.0f);
        if (u.pn < 2) {
            EPI_FOR_ROWS { const int row = EPI_ROW; const float r = rs[ai * 4 + m];
                const f32x4 x1a = acc[ai][0][m][0] * r, x1b = acc[ai][0][m][1] * r, x2a = acc[ai][1][m][0] * r, x2b = acc[ai][1][m][1] * r;
                bf16_t* dst = CKV + (size_t)row * 512 + u.pn * 256 + wc * 32 + 8 * fq; *(u32x4*)dst = pk8(x1a, x1b); *(u32x4*)(dst + 128) = pk8(x2a, x2b);
                float ss = 0.f;
#pragma unroll
                for (int e = 0; e < 4; ++e) ss += x1a[e] * x1a[e] + x1b[e] * x1b[e] + x2a[e] * x2a[e] + x2b[e] * x2b[e];
                ss += __shfl_xor(ss, 16); ss += __shfl_xor(ss, 32);
                if (fq == 0) ssq2[(size_t)row * 8 + u.pn * 4 + wc] = ss; }
        } else if (wc == 0) { const int f0 = 8 * fq;
#pragma unroll
            for (int aim = 0; aim < 4; ++aim) { const int ai = aim >> 1, mb = (aim & 1) * 2; f32x4 c0[4], c1[4], s0[4], s1[4];
#pragma unroll
                for (int m = mb; m < mb + 2; ++m) { const int i = (EPI_ROW & 2047) + 16;     const float* cp = cosm + i * 32 + f0; const float* sp = sinm + i * 32 + f0;
                    c0[m] = *(const f32x4*)cp; c1[m] = *(const f32x4*)(cp + 4); s0[m] = *(const f32x4*)sp; s1[m] = *(const f32x4*)(sp + 4); }
#pragma unroll
                for (int m = mb; m < mb + 2; ++m) { const float r = rs[ai * 4 + m]; bf16_t* dst = Kr + (size_t)EPI_ROW * 64 + f0; u32x4 lo, hi;
                    rope8(lo, hi, acc[ai][0][m][0] * r, acc[ai][0][m][1] * r, acc[ai][1][m][0] * r, acc[ai][1][m][1] * r, c0[m], c1[m], s0[m], s1[m]);
                    *(u32x4*)dst = lo; *(u32x4*)(dst + 32) = hi; } } }
    }
};
struct EpiKvb {
    static constexpr bool PERM = true, AFTER_DRAIN = false; typedef PreNone Pre;
    bf16_t* Kn; bf16_t* V; const float* ssq2;
    DI void prefetch(Pre&, const pg8::Unit&, int, int, int) const {}
    DI void operator()(AccRef acc, const Pre&, const pg8::Unit& u, int wr, int wc, int fr, int fq) const {
        asm volatile("" : "+v"(fr), "+v"(fq));
        const int cb = u.pn * 128 + wc * 32 + 8 * fq, row0 = u.pm * 256 + wr * 64 + fr;
        float rs[8]; rstd_rows<2, 8>(rs, ssq2, row0, fq, 1.0f / 512.0f);
        EPI_FOR_ROWS { const int row = EPI_ROW; const float r = rs[ai * 4 + m];
            *(u32x4*)(Kn + (size_t)row * DM + cb) = pk8(acc[ai][0][m][0] * r, acc[ai][0][m][1] * r); *(u32x4*)(V + (size_t)row * DM + cb) = pk8(acc[ai][1][m][0] * r, acc[ai][1][m][1] * r); }
    }
};
struct EpiQa {
    static constexpr bool PERM = true, AFTER_DRAIN = false; typedef PreRstd Pre;
    bf16_t* CQ; const float* ssq; float* ssq3;
    DI void prefetch(Pre& pre, const pg8::Unit& u, int wr, int fr, int fq) const { rstd_load(pre, ssq, u.pm * 256 + wr * 64 + fr); }
    DI void operator()(AccRef acc, const Pre& pre, const pg8::Unit& u, int wr, int wc, int fr, int fq) const {
        asm volatile("" : "+v"(fr), "+v"(fq));
        const int row0 = u.pm * 256 + wr * 64 + fr;
        float rs[8]; rstd_reduce(rs, pre, 1.0f / 1024.0f);
        EPI_FOR_ROWS { const int row = EPI_ROW; const float r = rs[ai * 4 + m];
            const f32x4 x1a = acc[ai][0][m][0] * r, x1b = acc[ai][0][m][1] * r, x2a = acc[ai][1][m][0] * r, x2b = acc[ai][1][m][1] * r;
            bf16_t* dst = CQ + (size_t)row * 768 + u.pn * 256 + wc * 32 + 8 * fq; *(u32x4*)dst = pk8(x1a, x1b); *(u32x4*)(dst + 128) = pk8(x2a, x2b);
            float ss = 0.f;
#pragma unroll
            for (int e = 0; e < 4; ++e) ss += x1a[e] * x1a[e] + x1b[e] * x1b[e] + x2a[e] * x2a[e] + x2b[e] * x2b[e];
            ss += __shfl_xor(ss, 16); ss += __shfl_xor(ss, 32);
            if (fq == 0) ssq3[(size_t)row * 16 + u.pn * 4 + wc] = ss; }
    }
};
struct EpiQb {
    static constexpr bool PERM = true, AFTER_DRAIN = false; typedef PreNone Pre;
    bf16_t* Qn; bf16_t* Qr; const float* ssq3; const float* cosm; const float* sinm;
    DI void prefetch(Pre&, const pg8::Unit&, int, int, int) const {}
    DI void operator()(AccRef acc, const Pre&, const pg8::Unit& u, int wr, int wc, int fr, int fq) const {
        asm volatile("" : "+v"(fr), "+v"(fq));
        const int row0 = u.pm * 256 + wr * 64 + fr;
        float rs[8]; rstd_rows<3, 16>(rs, ssq3, row0, fq, 1.0f / 768.0f);
        if (u.pn < 4) {
            EPI_FOR_ROWS { const float r = rs[ai * 4 + m]; bf16_t* dst = Qn + (size_t)EPI_ROW * DM + u.pn * 256 + wc * 32 + 8 * fq;
                *(u32x4*)dst = pk8(acc[ai][0][m][0] * r, acc[ai][0][m][1] * r); *(u32x4*)(dst + 128) = pk8(acc[ai][1][m][0] * r, acc[ai][1][m][1] * r); }
        } else { const int f0 = 8 * fq, head = 4 * (u.pn - 4) + wc;
#pragma unroll
            for (int aim = 0; aim < 4; ++aim) { const int ai = aim >> 1, mb = (aim & 1) * 2; f32x4 c0[4], c1[4], s0[4], s1[4];
#pragma unroll
                for (int m = mb; m < mb + 2; ++m) { const int i = (EPI_ROW & 2047) + 16;     const float* cp = cosm + i * 32 + f0; const float* sp = sinm + i * 32 + f0;
                    c0[m] = *(const f32x4*)cp; c1[m] = *(const f32x4*)(cp + 4); s0[m] = *(const f32x4*)sp; s1[m] = *(const f32x4*)(sp + 4); }
#pragma unroll
                for (int m = mb; m < mb + 2; ++m) { const float r = rs[ai * 4 + m]; bf16_t* dst = Qr + (size_t)EPI_ROW * 512 + head * 64 + f0; u32x4 lo, hi;
                    rope8(lo, hi, acc[ai][0][m][0] * r, acc[ai][0][m][1] * r, acc[ai][1][m][0] * r, acc[ai][1][m][1] * r, c0[m], c1[m], s0[m], s1[m]);
                    *(u32x4*)dst = lo; *(u32x4*)(dst + 32) = hi; } } }
    }
};
struct EpiNull { static constexpr bool PERM = true, AFTER_DRAIN = false; typedef PreNone Pre;
    DI void prefetch(Pre&, const pg8::Unit&, int, int, int) const {} float* sink;
    DI void operator()(AccRef acc, const Pre&, const pg8::Unit& u, int wr, int wc, int fr, int fq) const { float s = 0.f;
        EPI_FOR_ROWS { s += acc[ai][0][m][0][0] + acc[ai][1][m][1][3] + acc[ai][0][m][1][2] + acc[ai][1][m][0][1]; }
        if (s == 123.456f) sink[0] = s; } };
template <class Epi> DI void run_gemm(LAS unsigned char* lds, const bf16_t* A, int lda, const bf16_t* Bt, int N, int K, const Epi& E) {
    pg8::Gemm g{A, Bt, MR, N, K, lda}; pg8::StaticOrder S; S.init(MR, N, (int)gridDim.x, (int)blockIdx.x);
    pg8::gemm_phase<Epi, pg8::StaticOrder>(lds, g, S, E);
}

DI int wmap(int type, int n, int& which, float& nscale) {
    which = 0; nscale = 1.0f;
    if (type == 0) return n;
    if (type == 1) { if (n >= 1024 && n < 2048) nscale = 0.0625f; return n; }
    if (type == 2) { const int g = n >> 8, s = (n >> 7) & 1, j = n & 127; which = s; return g * 128 + j; }
    if (type == 3) { if (n < 512) return n; const int c = n - 512; if (c < 32) return 512 + c; if (c >= 128 && c < 160) return 544 + (c - 128); return -1; }
      { if (n < 1024) { const int head = n >> 7, dim = n & 127; return head * 192 + dim; }
        const int c0 = n - 1024, tt = c0 >> 8, c = c0 & 255, half = c >> 7, c1 = c & 127, hh = c1 >> 5, i = c1 & 31, head = 4 * tt + hh; return head * 192 + 128 + 32 * half + i; }
}
DI int otid() { int t = threadIdx.x; asm volatile("" : "+v"(t)); return t; }
DI void convert_job(const float* jsrc, const float* jsrc2, const float* jgain, bf16_t* jdst, const int jK, const int jNsrc, const int jN, const int jtype, const float jscale, LAS unsigned char* lds, const int first, const int stride) {
    const int tid = otid(), nTk = jK >> 6, ntiles = (jN >> 6) * nTk;
    LAS bf16_t* T = (LAS bf16_t*)lds;
    for (int tile = first; tile < ntiles; tile += stride) {
        const int tn = tile / nTk, tk = tile - tn * nTk, n0 = tn * 64, k0 = tk * 64;
        { const int kl = tid >> 3, n8 = (tid & 7) * 8; int which; float ns; const int sc = wmap(jtype, n0 + n8, which, ns);
          f32x4 a = {0.f, 0.f, 0.f, 0.f}, b = a;
          if (sc >= 0) { const float* s = (which ? jsrc2 : jsrc) + (size_t)(k0 + kl) * jNsrc + sc; a = *(const f32x4*)s; b = *(const f32x4*)(s + 4);
              const float f = (jgain ? jgain[k0 + kl] : 1.0f) * jscale * ns; a *= f; b *= f; }
          const unsigned w0 = pk2(a[0], a[1]), w1 = pk2(a[2], a[3]), w2 = pk2(b[0], b[1]), w3 = pk2(b[2], b[3]);
          T[(n8 + 0) * 72 + kl] = (bf16_t)(w0 & 0xffffu); T[(n8 + 1) * 72 + kl] = (bf16_t)(w0 >> 16); T[(n8 + 2) * 72 + kl] = (bf16_t)(w1 & 0xffffu); T[(n8 + 3) * 72 + kl] = (bf16_t)(w1 >> 16);
          T[(n8 + 4) * 72 + kl] = (bf16_t)(w2 & 0xffffu); T[(n8 + 5) * 72 + kl] = (bf16_t)(w2 >> 16); T[(n8 + 6) * 72 + kl] = (bf16_t)(w3 & 0xffffu); T[(n8 + 7) * 72 + kl] = (bf16_t)(w3 >> 16); }
        __syncthreads();
        { const int nl = tid >> 3, k8 = (tid & 7) * 8; const u32x4 v = *(const LAS u32x4*)(T + nl * 72 + k8); *(u32x4*)(jdst + (size_t)(n0 + nl) * jK + k0 + k8) = v; }
        __syncthreads();
    }
}
DI void convert_set1(const Params& p, LAS unsigned char* lds) {
    bf16_t* W1 = (bf16_t*)(p.ws + OFF_W1);
    for (int l = 0; l < 2; ++l) { bf16_t* wl = W1 + l * W1_LAYER;
        convert_job(p.ret_w_in + (size_t)l * 1024 * 6144, nullptr, p.norm_mix_g + l * 1024, wl, 1024, 6144, 6144, 1, 1.0f, lds, (int)blockIdx.x, (int)gridDim.x);
        convert_job(p.ret_w_o + (size_t)l * 2048 * 1024, nullptr, nullptr, wl + W1_WO, 2048, 1024, 1024, 0, 1.0f, lds, (int)blockIdx.x, (int)gridDim.x);
        convert_job(p.ffn_w1 + (size_t)l * 1024 * FFH, p.ffn_w3 + (size_t)l * 1024 * FFH, p.norm_ffn_g + l * 1024, wl + W1_WUP, 1024, FFH, 5632, 2, 1.0f, lds, (int)blockIdx.x, (int)gridDim.x);
        convert_job(p.ffn_w2 + (size_t)l * FFH * 1024, nullptr, nullptr, wl + W1_WDN, FFH, 1024, 1024, 0, 1.0f, lds, (int)blockIdx.x, (int)gridDim.x); }
}
DI void convert_set2(const Params& p, LAS unsigned char* lds, const int first, const int stride) {
    bf16_t* W2 = (bf16_t*)(p.ws + OFF_W2);
    convert_job(p.mla_w_kv_a, nullptr, p.mla_norm_kv_g, W2, 1024, 576, 768, 3, 1.0f, lds, first, stride);
    convert_job(p.mla_w_kv_b, nullptr, p.mla_kv_a_norm_g, W2 + W2_KVB, 512, 2048, 2048, 0, 1.0f, lds, first, stride);
    for (int jj = 0; jj < 2; ++jj) { bf16_t* wl = W2 + W2_L0 + jj * W2_LAYER; const int l = 2 + jj;
        convert_job(p.mla_w_q_a + (size_t)jj * 1024 * 768, nullptr, p.norm_mix_g + l * 1024, wl, 1024, 768, 768, 0, 1.0f, lds, first, stride);
        convert_job(p.mla_w_q_b + (size_t)jj * 768 * 1536, nullptr, p.mla_q_a_norm_g + jj * 768, wl + W2_WQB, 768, 1536, 1536, 4, 0.07216878364870322f * 1.4426950408889634f, lds, first, stride);
        convert_job(p.mla_w_o + (size_t)jj * 1024 * 1024, nullptr, nullptr, wl + W2_WOM, 1024, 1024, 1024, 0, 1.0f, lds, first, stride);
        convert_job(p.ffn_w1 + (size_t)l * 1024 * FFH, p.ffn_w3 + (size_t)l * 1024 * FFH, p.norm_ffn_g + l * 1024, wl + W2_WUP, 1024, FFH, 5632, 2, 1.0f, lds, first, stride);
        convert_job(p.ffn_w2 + (size_t)l * FFH * 1024, nullptr, nullptr, wl + W2_WDN, FFH, 1024, 1024, 0, 1.0f, lds, first, stride); }
}

DI void prologue_rows(const Params& p) {
    const int tid = otid(), lane = tid & 63, gw = blockIdx.x * 8 + (tid >> 6), nw = gridDim.x * 8;
    bf16_t* HB = (bf16_t*)(p.ws + OFF_HB); float* SSQ = (float*)(p.ws + OFF_SSQ);
    for (int row0 = gw; row0 < MR; row0 += 2 * nw) {
        f32x4 v[2][4]; int rows[2];
#pragma unroll
        for (int u = 0; u < 2; ++u) { const int rw = row0 + u * nw, row = rw < MR ? rw : row0; rows[u] = row; const float* src = p.x + ((size_t)row << 10);
#pragma unroll
            for (int c = 0; c < 4; ++c) v[u][c] = *(const f32x4*)(src + c * 256 + lane * 4); }
#pragma unroll
        for (int u = 0; u < 2; ++u) { if (u == 1 && row0 + nw >= MR) break; const int row = rows[u]; float ss = 0.f;
#pragma unroll
            for (int c = 0; c < 4; ++c) { const int col = c * 256 + lane * 4; const f32x4 w4 = v[u][c];
                ss += (w4[0] * w4[0] + w4[1] * w4[1]) + (w4[2] * w4[2] + w4[3] * w4[3]);
                u32x2 w; w.x = pk2(w4[0], w4[1]); w.y = pk2(w4[2], w4[3]); *(u32x2*)(HB + (size_t)row * DM + col) = w; }
            ss = wsum(ss);
            if (lane == 0) { SSQ[row] = ss; SSQ[MR + row] = 0.f; } } }
    const int gt = blockIdx.x * 512 + tid, nt = gridDim.x * 512;
    float* cosr = (float*)(p.ws + OFF_COSR); float* sinr = (float*)(p.ws + OFF_SINR); float* cosm = (float*)(p.ws + OFF_COSM); float* sinm = (float*)(p.ws + OFF_SINM);
    for (int idx = gt; idx < NPOS * 160; idx += nt) { const int i = idx / 160, f = idx - i * 160; const bool isr = f < 128; const int ff = isr ? f : f - 128;
        const float inv = 1.0f / exp2f((isr ? (float)ff * (1.0f / 128.0f) : (float)ff * (1.0f / 32.0f)) * 13.287712379549449f);
        const float ang = (float)i * inv; const double rev = (double)ang * 0.15915494309189535; const float fr = (float)(rev - __builtin_rint(rev));
        const float c = __builtin_amdgcn_cosf(fr), s = __builtin_amdgcn_sinf(fr);
        if (isr) { cosr[i * 128 + ff] = c; sinr[i * 128 + ff] = s; } else { cosm[i * 32 + ff] = c; sinm[i * 32 + ff] = s; } }
}

template <bool DUMMY> DI void ret_phase(LAS unsigned char* lds, bf16_t* PROJ, bf16_t* HBD, const float* S0l) {
    constexpr int QS = 520  , KS = 576, SS = 144, OQ = 0, OK = 33792, OV = OK + 36864, OS = OV + 36864;
    const int tid = otid(), wave = tid >> 6, lane = tid & 63, r = lane & 31, h = lane >> 5, fr = lane & 15, fq = lane >> 4, g1 = (lane >> 4) & 1, q4 = (lane & 15) >> 2, p4 = lane & 3;
    for (int item = blockIdx.x; item < 256; item += gridDim.x) {
        const int b = item >> 3, hd = (item >> 1) & 3, half = item & 1;
        const float lg2 = log2f(1.0f - exp2f(-5.0f - (float)hd)), cdec = ex2(lg2 * 64.0f);
        const int cw = wave * 32;
        f32x16 S[8];
        int ls_ = lane; asm volatile("" : "+v"(ls_)); const float* s0p = S0l + (size_t)(hd * 256 + 4 * (ls_ >> 5)) * 512 + half * 256 + cw + (ls_ & 31);
#pragma unroll
        for (int t = 0; t < 8; ++t)
#pragma unroll
            for (int e = 0; e < 16; ++e) S[t][e] = s0p[(32 * t + (e & 3) + 8 * (e >> 2)) * 512];
        for (int c = 0; c < 32; ++c) {
            float lg = lg2; int lc_ = lane; asm volatile("" : "+v"(lg), "+v"(lc_));
            const int r = lc_ & 31, h = lc_ >> 5, fr = lc_ & 15, fq = lc_ >> 4, g1 = (lc_ >> 4) & 1, q4 = (lc_ & 15) >> 2, p4 = lc_ & 3;
            bf16_t* base = PROJ + ((size_t)b * LB + c * 64) * RIN;
            int toff = (tid >> 5) * RIN + (tid & 31) * 8, ooff = (lane >> 2) * RIN + 2048 + hd * 512 + half * 256 + cw + (lane & 3) * 8; asm volatile("" : "+v"(toff), "+v"(ooff));
#pragma unroll
            for (int i = 0; i < 4; ++i) { const int row = (tid >> 5) + 16 * i, seg = tid & 31; const bf16_t* s = base + toff + i * 16 * RIN;
                const u32x4 vq = *(const u32x4*)(s + hd * 256), vk = *(const u32x4*)(s + 1024 + hd * 256), vv = *(const u32x4*)(s + 2048 + hd * 512 + half * 256);
                { u32x2 lo_, hi_; lo_.x = vq.x; lo_.y = vq.y; hi_.x = vq.z; hi_.y = vq.w; *(LAS u32x2*)(lds + OQ + row * QS + seg * 16) = lo_; *(LAS u32x2*)(lds + OQ + row * QS + seg * 16 + 8) = hi_; } *(LAS u32x4*)(lds + OK + row * KS + seg * 16) = vk; *(LAS u32x4*)(lds + OV + row * KS + seg * 16) = vv; }
            __syncthreads();
#pragma unroll
            for (int t2 = 0; t2 < 2; ++t2) { const int tt = wave * 2 + t2, i0 = (tt >> 2) * 16, j0 = (tt & 3) * 16; f32x4 a4 = {0.f, 0.f, 0.f, 0.f};
#pragma unroll
                for (int ks = 0; ks < 8; ++ks) { const bf16x8 ka = *(const LAS bf16x8*)(lds + OK + (j0 + fr) * KS + (32 * ks + 8 * fq) * 2), qb = cat8u(*(const LAS u32x2*)(lds + OQ + (i0 + fr) * QS + (32 * ks + 8 * fq) * 2), *(const LAS u32x2*)(lds + OQ + (i0 + fr) * QS + (32 * ks + 8 * fq) * 2 + 8));
                    a4 = MFMA16(ka, qb, a4); }
                const int ii = i0 + fr, jb = j0 + 4 * fq;
                float frq = (float)(fr - 4 * fq); asm volatile("" : "+v"(frq));
#pragma unroll
                for (int e = 0; e < 4; ++e) a4[e] *= ex2(lg * fabsf(frq + (float)(i0 - j0 - e)));
                u32x2 w; w.x = pk2(a4[0], a4[1]); w.y = pk2(a4[2], a4[3]); *(LAS u32x2*)(lds + OS + ii * SS + jb * 2) = w; }
            __syncthreads();
            bf16x8 vB[4];
#pragma unroll
            for (int ks = 0; ks < 4; ++ks) { const LAS unsigned char* a = lds + OV + (16 * ks + 8 * h + q4) * KS + (cw + 16 * g1 + 4 * p4) * 2; vB[ks] = cat8(vtr(a), vtr(a + 4 * KS)); }
            f32x16 o0, o1;
#pragma unroll
            for (int e = 0; e < 16; ++e) { o0[e] = 0.f; o1[e] = 0.f; }
#pragma unroll
            for (int t = 0; t < 8; ++t) {
                { const bf16x8 sb = pack_acc<0>(S[t]); const LAS unsigned char* qa = lds + OQ + r * QS + (32 * t + 4 * h) * 2;
                  const bf16x8 A0 = cat8u(*(const LAS u32x2*)qa, *(const LAS u32x2*)(qa + 16)), A1 = cat8u(*(const LAS u32x2*)(qa + 32 * QS), *(const LAS u32x2*)(qa + 32 * QS + 16));
                  o0 = MFMA32(A0, sb, o0); o1 = MFMA32(A1, sb, o1); }
                { const bf16x8 sb = pack_acc<8>(S[t]); const LAS unsigned char* qa = lds + OQ + r * QS + (32 * t + 16 + 4 * h) * 2;
                  const bf16x8 A0 = cat8u(*(const LAS u32x2*)qa, *(const LAS u32x2*)(qa + 16)), A1 = cat8u(*(const LAS u32x2*)(qa + 32 * QS), *(const LAS u32x2*)(qa + 32 * QS + 16));
                  o0 = MFMA32(A0, sb, o0); o1 = MFMA32(A1, sb, o1); }
                }
#pragma unroll
            for (int e = 0; e < 16; ++e) { float hf4 = (float)(4 * h); asm volatile("" : "+v"(hf4)); const float tk = hf4 + (float)((e & 3) + 8 * (e >> 2) + 1); o0[e] *= ex2(lg * tk); o1[e] *= ex2(lg * (tk + 32.f)); }
#pragma unroll
            for (int ks = 0; ks < 4; ++ks) { const LAS unsigned char* sa = lds + OS + r * SS + (16 * ks + 8 * h) * 2;
                o0 = MFMA32(*(const LAS bf16x8*)sa, vB[ks], o0); o1 = MFMA32(*(const LAS bf16x8*)(sa + 32 * SS), vB[ks], o1); }
            { LAS bf16_t* vs = (LAS bf16_t*)(lds + OV) + cw + r;
#pragma unroll
              for (int e = 0; e < 16; ++e) { const int tk = (e & 3) + 8 * (e >> 2) + 4 * h; vs[tk * (KS / 2)] = (bf16_t)(pk2(o0[e], 0.f) & 0xffffu); vs[(tk + 32) * (KS / 2)] = (bf16_t)(pk2(o1[e], 0.f) & 0xffffu); }
              bf16_t* od = base + ooff;
              const LAS unsigned char* os = lds + OV + (lane >> 2) * KS + (cw + (lane & 3) * 8) * 2;
#pragma unroll
              for (int ps = 0; ps < 4; ++ps) { const u32x4 v = *(const LAS u32x4*)(os + ps * 16 * KS);
                  if (DUMMY) *(u32x4*)(HBD + ((size_t)b * LB + c * 64 + (lane >> 2) + 16 * ps) * DM + ((hd * 512 + half * 256 + cw + (lane & 3) * 8) & 1023)) = v;
                  else *(u32x4*)(od + (size_t)ps * 16 * RIN) = v; } }
            __builtin_amdgcn_sched_barrier(0);
#pragma unroll
            for (int ks = 0; ks < 4; ++ks) { float hf4 = (float)(4 * h); asm volatile("" : "+v"(hf4)); u32x4 w = __builtin_bit_cast(u32x4, vB[ks]); const float t0 = (float)(63 - 16 * ks) - 2.0f * hf4;
                u32x4 o; o.x = pk2(bflo(w.x) * ex2(lg * t0), bfhi(w.x) * ex2(lg * (t0 - 1.f))); o.y = pk2(bflo(w.y) * ex2(lg * (t0 - 2.f)), bfhi(w.y) * ex2(lg * (t0 - 3.f)));
                o.z = pk2(bflo(w.z) * ex2(lg * (t0 - 4.f)), bfhi(w.z) * ex2(lg * (t0 - 5.f))); o.w = pk2(bflo(w.w) * ex2(lg * (t0 - 6.f)), bfhi(w.w) * ex2(lg * (t0 - 7.f)));
                vB[ks] = __builtin_bit_cast(bf16x8, o); }
            __builtin_amdgcn_sched_barrier(0);
#pragma unroll
            for (int t = 0; t < 8; ++t) { S[t] *= cdec;
#pragma unroll
                for (int ks = 0; ks < 4; ++ks) { const LAS unsigned char* a = lds + OK + (16 * ks + 8 * h + q4) * KS + (32 * t + 16 * g1 + 4 * p4) * 2;
                    S[t] = MFMA32(cat8(vtr(a), vtr(a + 4 * KS)), vB[ks], S[t]); }
                }
            __syncthreads();
        }
    }
}
DI void gn_phase(const Params& p, int layer, bf16_t* PROJ) {
    const int tid = otid(), lane = tid & 63, gw = blockIdx.x * 8 + (tid >> 6), nw = gridDim.x * 8;
    const float* gg = p.ret_gn_g + layer * 2048;
    for (int row0 = gw; row0 < MR; row0 += 2 * nw) {
        u32x4 vo4[2][4], vg4[2][4]; bf16_t* prs[2];
#pragma unroll
        for (int u = 0; u < 2; ++u) { const int rw = row0 + u * nw, row = rw < MR ? rw : row0; prs[u] = PROJ + (size_t)row * RIN + 2048 + lane * 8;
#pragma unroll
            for (int hd = 0; hd < 4; ++hd) { vo4[u][hd] = *(const u32x4*)(prs[u] + hd * 512); vg4[u][hd] = *(const u32x4*)(prs[u] + 2048 + hd * 512); } }
#pragma unroll
        for (int u = 0; u < 2; ++u) { if (u == 1 && row0 + nw >= MR) break; bf16_t* pr = prs[u];
#pragma unroll
            for (int hd = 0; hd < 4; ++hd) { const u32x4 vo = vo4[u][hd], vg = vg4[u][hd];
                float o[8] = {bflo(vo.x), bfhi(vo.x), bflo(vo.y), bfhi(vo.y), bflo(vo.z), bfhi(vo.z), bflo(vo.w), bfhi(vo.w)};
                float g[8] = {bflo(vg.x), bfhi(vg.x), bflo(vg.y), bfhi(vg.y), bflo(vg.z), bfhi(vg.z), bflo(vg.w), bfhi(vg.w)};
                float s = 0.f;
#pragma unroll
                for (int e = 0; e < 8; ++e) s += o[e];
                const float mu = wsum(s) * (1.0f / 512.0f); float q = 0.f;
#pragma unroll
                for (int e = 0; e < 8; ++e) { o[e] -= mu; q += o[e] * o[e]; }
                const float rstd = rsqrtf(wsum(q) * (1.0f / 512.0f) + GN_EPS);
                const f32x4 ga = *(const f32x4*)(gg + hd * 512 + lane * 8), gb = *(const f32x4*)(gg + hd * 512 + lane * 8 + 4);
                f32x4 ra, rb;
#pragma unroll
                for (int e = 0; e < 4; ++e) { ra[e] = silu_f(g[e]) * (o[e] * rstd * ga[e]); rb[e] = silu_f(g[4 + e]) * (o[4 + e] * rstd * gb[e]); }
                *(u32x4*)(pr + 2048 + hd * 512) = pk8(ra, rb); } } }
}

DI void attn_phase(LAS unsigned char* lds, const bf16_t* Qn, const bf16_t* Qr, const bf16_t* Kn, const bf16_t* Kr, const bf16_t* V, bf16_t* AO, const bf16_t* KnM, const bf16_t* KrM, const bf16_t* VM) {
    constexpr int KST = 400, VST = 320, OVB = 64 * KST, BUF = OVB + 64 * VST;
    const int tid = otid(), wave = __builtin_amdgcn_readfirstlane(tid >> 6), lane = tid & 63, r = lane & 31, h = lane >> 5, g1 = (lane >> 4) & 1, q4 = (lane & 15) >> 2, p4 = lane & 3;
    const int G = (int)gridDim.x, vcu = (G == 256) ? ((int)blockIdx.x & 7) * 32 + ((int)blockIdx.x >> 3) : (int)blockIdx.x;
    for (int item = vcu; item < 1024; item += G) {
        const int bh = item >> 2, mbr = item & 3;
        const int b = bh >> 3, hd = bh & 7; const size_t rb = (size_t)b * LB;
        const char* knBase = (const char*)(Kn + rb * DM + hd * 128); const char* vBase = (const char*)(V + rb * DM + hd * 128); const unsigned krDelta = (unsigned)((const char*)(Kr + rb * 64) - knBase);
        const char* knM = (const char*)(KnM + hd * 128); const char* vM = (const char*)(VM + hd * 128); const unsigned krDeltaM = (unsigned)((const char*)KrM - knM);
        for (int uu = 0; uu < 2; ++uu) { const int qb = uu == 0 ? mbr + 1 : 8 - mbr;
            const int ntiles = 4 * qb + 1, cwv = 4 * (qb - 1) + 1 + (wave >> 1), q0 = (qb - 1) * 256;
            const bool active = true;
            const size_t qrow = rb + q0 + wave * 32 + r;
            bf16x8 qf[12];
            if (active) {
#pragma unroll
                for (int ks = 0; ks < 8; ++ks) qf[ks] = *(const bf16x8*)(Qn + qrow * DM + hd * 128 + 16 * ks + 8 * h);
#pragma unroll
                for (int ks = 0; ks < 4; ++ks) qf[8 + ks] = *(const bf16x8*)(Qr + qrow * 512 + hd * 64 + 16 * ks + 8 * h);
            } else {
#pragma unroll
                for (int ks = 0; ks < 12; ++ks) qf[ks] = (bf16x8){0, 0, 0, 0, 0, 0, 0, 0};
            }
            float mrun = -1.0e30f, lrun = 0.f;
            f32x16 O[4];
#pragma unroll
            for (int t = 0; t < 4; ++t)
#pragma unroll
                for (int e = 0; e < 16; ++e) O[t][e] = 0.f;
#define ATT_DMA(j, bufi) do { LAS unsigned char* bb_ = lds + (bufi) * BUF; const bool m0_ = (j) == 0; const char* kb0_ = m0_ ? knM : knBase; const char* vb0_ = m0_ ? vM : vBase; \
                const unsigned jn_ = m0_ ? 0u : (unsigned)((j) - 1) * 131072u, jr_ = m0_ ? krDeltaM : (unsigned)((j) - 1) * 8192u + krDelta; int ln_ = lane; asm volatile("" : "+v"(ln_)); \
                _Pragma("unroll") for (int i_ = 0; i_ < 6; ++i_) { const int I_ = wave + 8 * i_; \
                    if (I_ < 25) { const int o_ = I_ * 1024 + ln_ * 16, row_ = o_ / KST, seg_ = (o_ - row_ * KST) >> 4; const bool isr_ = seg_ >= 16 && seg_ < 24; \
                        const unsigned vo_ = isr_ ? jr_ + (unsigned)(row_ * 128 + (seg_ - 16) * 16) : jn_ + (unsigned)(row_ * 2048 + (seg_ < 16 ? seg_ * 16 : 0)); \
                        __builtin_amdgcn_global_load_lds((const unsigned*)(kb0_ + (size_t)vo_), (LAS unsigned*)(bb_ + I_ * 1024), 16, 0, 0); } \
                    else if (I_ < 45) { const int o_ = (I_ - 25) * 1024 + ln_ * 16, row_ = o_ / VST, seg_ = (o_ - row_ * VST) >> 4; \
                        const unsigned vo_ = jn_ + (unsigned)(row_ * 2048 + (seg_ < 16 ? seg_ * 16 : 0)); \
                        __builtin_amdgcn_global_load_lds((const unsigned*)(vb0_ + (size_t)vo_), (LAS unsigned*)(bb_ + OVB + (I_ - 25) * 1024), 16, 0, 0); } } } while (0)
#define ATT_DMA_WAIT(ahead) do { if (!(ahead)) asm volatile("s_waitcnt vmcnt(0)" ::: "memory"); else if (wave < 5) asm volatile("s_waitcnt vmcnt(6)" ::: "memory"); else asm volatile("s_waitcnt vmcnt(5)" ::: "memory"); } while (0)
            ATT_DMA(0, 0); if (ntiles > 1) ATT_DMA(1, 1); ATT_DMA_WAIT(ntiles > 1);
            asm volatile("s_waitcnt lgkmcnt(0)" ::: "memory"); __builtin_amdgcn_s_barrier(); asm volatile("" ::: "memory");
            for (int j = 0; j < ntiles; ++j) {
                const bool more = (j + 2 < ntiles);
                if (more) ATT_DMA(j + 2, (j + 2) % 3);
                if (active && j <= cwv) {
                    const LAS unsigned char* kb = lds + (j % 3) * BUF; const LAS unsigned char* vb = kb + OVB;
                    f32x16 s0, s1;
#pragma unroll
                    for (int e = 0; e < 16; ++e) { s0[e] = 0.f; s1[e] = 0.f; }
                    const LAS unsigned char* ka = kb + r * KST + 16 * h;
#define ATT_LDK(dst, g) do { _Pragma("unroll") for (int i_ = 0; i_ < 2; ++i_) { dst[2 * i_] = *(const LAS bf16x8*)(ka + 32 * (2 * (g) + i_)); dst[2 * i_ + 1] = *(const LAS bf16x8*)(ka + 32 * KST + 32 * (2 * (g) + i_)); } } while (0)
#define ATT_MMK(src, g) do { s0 = MFMA32(src[0], qf[2 * (g)], s0); s1 = MFMA32(src[1], qf[2 * (g)], s1); __builtin_amdgcn_sched_barrier(0); s0 = MFMA32(src[2], qf[2 * (g) + 1], s0); s1 = MFMA32(src[3], qf[2 * (g) + 1], s1); } while (0)
#define ATT_SB __builtin_amdgcn_sched_barrier(0)
                    bf16x8 kA[4], kB[4];
                    ATT_LDK(kA, 0); ATT_LDK(kB, 1); ATT_SB;
                    ATT_MMK(kA, 0); ATT_SB; ATT_LDK(kA, 2); ATT_SB;
                    ATT_MMK(kB, 1); ATT_SB; ATT_LDK(kB, 3); ATT_SB;
                    ATT_MMK(kA, 2); ATT_SB; ATT_LDK(kA, 4); ATT_SB;
                    ATT_MMK(kB, 3); ATT_SB; ATT_LDK(kB, 5); ATT_SB;
                    ATT_MMK(kA, 4); ATT_SB;
                    ATT_MMK(kB, 5); ATT_SB;
                    const LAS unsigned char* va = vb + (4 * h + q4) * VST + (16 * g1 + 4 * p4) * 2;
#define ATT_TR(d, off) "ds_read_b64_tr_b16 %" #d ", %8 offset:" #off "\n\t"
#define ATT_LDV(dst, kk) do { u32x2 a0_, a1_, a2_, a3_, a4_, a5_, a6_, a7_; const unsigned vaddr_ = (unsigned)(size_t)(va + 16 * VST * (kk)); \
        asm volatile("ds_read_b64_tr_b16 %0, %8\n\tds_read_b64_tr_b16 %1, %8 offset:2560\n\tds_read_b64_tr_b16 %2, %8 offset:64\n\tds_read_b64_tr_b16 %3, %8 offset:2624\n\t" \
                     "ds_read_b64_tr_b16 %4, %8 offset:128\n\tds_read_b64_tr_b16 %5, %8 offset:2688\n\tds_read_b64_tr_b16 %6, %8 offset:192\n\tds_read_b64_tr_b16 %7, %8 offset:2752" \
                     : "=&v"(a0_), "=&v"(a1_), "=&v"(a2_), "=&v"(a3_), "=&v"(a4_), "=&v"(a5_), "=&v"(a6_), "=&v"(a7_) : "v"(vaddr_) : "memory"); \
        dst[0] = cat8u(a0_, a1_); dst[1] = cat8u(a2_, a3_); dst[2] = cat8u(a4_, a5_); dst[3] = cat8u(a6_, a7_); } while (0)
#define ATT_WV(dst) asm volatile("s_waitcnt lgkmcnt(0)" : "+v"(dst[0]), "+v"(dst[1]), "+v"(dst[2]), "+v"(dst[3]) :: "memory")
                    bf16x8 vA[4], vB[4];
                    ATT_LDV(vA, 0); ATT_SB;
                    if (j == 0) {
#pragma unroll
                        for (int e = 0; e < 16; ++e) { s0[e] = -1.0e30f; if (e < 8) s1[e] = -1.0e30f; } }
                    float mx = s0[0];
#pragma unroll
                    for (int e = 1; e < 16; ++e) mx = fmaxf(mx, s0[e]);
#pragma unroll
                    for (int e = 0; e < 16; ++e) mx = fmaxf(mx, s1[e]);
                    { const u32x2 sw_ = __builtin_amdgcn_permlane32_swap(__float_as_uint(mx), __float_as_uint(mx), false, false); mx = fmaxf(__uint_as_float(sw_.x), __uint_as_float(sw_.y)); }
                    float mnew = mrun, alpha = 1.0f;
                    const bool grow = !__all((int)(mx - mrun <= 8.0f));
                    if (grow) { mnew = fmaxf(mrun, mx); alpha = ex2(mrun - mnew); mrun = mnew; }
                    float rs = 0.f;
#pragma unroll
                    for (int e = 0; e < 16; ++e) { s0[e] = ex2(s0[e] - mnew); s1[e] = ex2(s1[e] - mnew); rs += s0[e] + s1[e]; }
                    { const u32x2 sw_ = __builtin_amdgcn_permlane32_swap(__float_as_uint(rs), __float_as_uint(rs), false, false); rs = __uint_as_float(sw_.x) + __uint_as_float(sw_.y); } lrun = lrun * alpha + rs;
                    if (grow) {
#pragma unroll
                        for (int t = 0; t < 4; ++t) O[t] *= alpha; }
                    const bf16x8 pb0 = pack_acc<0>(s0), pb1 = pack_acc<8>(s0), pb2 = pack_acc<0>(s1), pb3 = pack_acc<8>(s1);
#define ATT_MMV(src, pb) do { O[0] = MFMA32(src[0], pb, O[0]); O[1] = MFMA32(src[1], pb, O[1]); O[2] = MFMA32(src[2], pb, O[2]); O[3] = MFMA32(src[3], pb, O[3]); } while (0)
                    ATT_SB; ATT_WV(vA); ATT_LDV(vB, 1); ATT_SB;
                    ATT_MMV(vA, pb0); ATT_SB;
                    ATT_WV(vB); ATT_LDV(vA, 2); ATT_SB;
                    ATT_MMV(vB, pb1); ATT_SB;
                    ATT_WV(vA); ATT_LDV(vB, 3); ATT_SB;
                    ATT_MMV(vA, pb2); ATT_SB;
                    ATT_WV(vB); ATT_SB;
                    ATT_MMV(vB, pb3);
#undef ATT_WV
#undef ATT_TR
#undef ATT_LDK
#undef ATT_SB
#undef ATT_MMK
#undef ATT_LDV
#undef ATT_MMV
                }
                ATT_DMA_WAIT(more);
                asm volatile("s_waitcnt lgkmcnt(0)" ::: "memory"); __builtin_amdgcn_s_barrier(); asm volatile("" ::: "memory");
            }
#undef ATT_DMA
#undef ATT_DMA_WAIT
            if (active) { const float inv = 1.0f / lrun; bf16_t* od = AO + qrow * DM + hd * 128 + 4 * h;
#pragma unroll
                for (int t = 0; t < 4; ++t)
#pragma unroll
                    for (int g4 = 0; g4 < 4; ++g4) { u32x2 w; w.x = pk2(O[t][4 * g4] * inv, O[t][4 * g4 + 1] * inv); w.y = pk2(O[t][4 * g4 + 2] * inv, O[t][4 * g4 + 3] * inv);
                        *(u32x2*)(od + 32 * t + 8 * g4) = w; } }
        }
    }
}

DI void final_phase(const Params& p) {
    const int tid = otid(), lane = tid & 63, gw = blockIdx.x * 8 + (tid >> 6), nw = gridDim.x * 8;
    const float* SSQ = (const float*)(p.ws + OFF_SSQ);
    f32x4 g[4];
#pragma unroll
    for (int c = 0; c < 4; ++c) g[c] = *(const f32x4*)(p.final_g + c * 256 + lane * 4);
    for (int rf = gw; rf < NB * SEQ; rf += 2 * nw) {
        const int rf2 = rf + nw; const bool has2 = rf2 < NB * SEQ; const int rfb = has2 ? rf2 : rf;
        float* o0 = p.out + ((size_t)rf << 10); float* o1 = p.out + ((size_t)rfb << 10);
        f32x4 v0[4], v1[4];
#pragma unroll
        for (int c = 0; c < 4; ++c) { v0[c] = *(const f32x4*)(o0 + c * 256 + lane * 4); v1[c] = *(const f32x4*)(o1 + c * 256 + lane * 4); }
        const float r0 = rsqrtf(SSQ[rf] * (1.0f / 1024.0f) + RMS_EPS), r1 = rsqrtf(SSQ[rfb] * (1.0f / 1024.0f) + RMS_EPS);
#pragma unroll
        for (int c = 0; c < 4; ++c) *(f32x4*)(o0 + c * 256 + lane * 4) = v0[c] * r0 * g[c];
        if (has2) {
#pragma unroll
            for (int c = 0; c < 4; ++c) *(f32x4*)(o1 + c * 256 + lane * 4) = v1[c] * r1 * g[c]; } }
}

#define XB_TMO      128
#define XB_XCNT(j)  (256  + 64 * (j))
#define XB_XSUB(j)  (1280 + 64 * (j))
#define XB_XGEN(j)  (2304 + 64 * (j))
#define XB_TOP      3328
#define XB_TOPGEN   3392
#define XCD_BAR_WORDS 3456
#define XB_SPIN_CAP (1u << 22)

__device__ __forceinline__ unsigned xb_ld(unsigned* p)              { return __hip_atomic_load(p, __ATOMIC_RELAXED, __HIP_MEMORY_SCOPE_AGENT); }
__device__ __forceinline__ unsigned xb_add(unsigned* p, unsigned v) { return __hip_atomic_fetch_add(p, v, __ATOMIC_RELAXED, __HIP_MEMORY_SCOPE_AGENT); }
__device__ __forceinline__ unsigned xb_xcc_id() { return (unsigned)__builtin_amdgcn_s_getreg((3 << 11) | 20) & 0xFu; }
#define XB_SPIN(cond, bar) do { unsigned _sp = 0; while (cond) { __builtin_amdgcn_s_sleep(1); \
    if ((++_sp & 255u) == 0u) { if (xb_ld(&(bar)[XB_TMO])) break; if (_sp > XB_SPIN_CAP) { atomicAdd(&(bar)[XB_TMO], 1u); break; } } } } while (0)

struct XcdBarrier {
    unsigned* bar; unsigned x;
    volatile LAS unsigned* st;
};

__device__ __forceinline__ XcdBarrier xcd_barrier_post(unsigned* bar, volatile LAS unsigned* st) {
    XcdBarrier b; b.bar = bar; b.x = xb_xcc_id(); b.st = st;
    if (threadIdx.x == 0) (void)xb_add(&bar[XB_XCNT(b.x)], 1u);
    return b;
}
__device__ __forceinline__ void xcd_barrier_complete(unsigned* bar, unsigned x, unsigned& nloc, unsigned& nx) {
    const unsigned G = gridDim.x * gridDim.y * gridDim.z;
    unsigned sum, cnt, mine, sp = 0u;
    for (;;) {
        sum = 0u; cnt = 0u; mine = 0u;
#pragma unroll
        for (unsigned j = 0; j < 16; ++j) { const unsigned c = xb_ld(&bar[XB_XCNT(j)]); sum += c; cnt += (c > 0u) ? 1u : 0u; mine = (j == x) ? c : mine; }
        if (sum == G) break;
        __builtin_amdgcn_s_sleep(1);
        if ((++sp & 255u) == 0u) { if (xb_ld(&bar[XB_TMO])) break; if (sp > XB_SPIN_CAP) { atomicAdd(&bar[XB_TMO], 1u); break; } }
    }
    nloc = mine > 0u ? mine : 1u; nx = cnt > 0u ? cnt : 1u;
}

__device__ __forceinline__ void xcd_barrier(const XcdBarrier& b) {
    asm volatile("s_waitcnt vmcnt(0)" ::: "memory");
    __syncthreads();
    if (threadIdx.x == 0) {
        unsigned* bar = b.bar;
        __builtin_amdgcn_s_waitcnt(0);
        unsigned nloc = b.st[0], nx = b.st[1];
        if (nloc == 0u) { xcd_barrier_complete(bar, b.x, nloc, nx); b.st[0] = nloc; b.st[1] = nx; }
        const unsigned old = xb_add(&bar[XB_XSUB(b.x)], 1u);
        const unsigned gen = old / nloc;
        if (old + 1u == (gen + 1u) * nloc) {
            __builtin_amdgcn_fence(__ATOMIC_RELEASE, "agent");
            asm volatile("s_waitcnt vmcnt(0)" ::: "memory");
            const unsigned og = xb_add(&bar[XB_TOP], 1u);
            const unsigned tg = og / nx;
            if (og + 1u == (tg + 1u) * nx) xb_add(&bar[XB_TOPGEN], 1u);
            else XB_SPIN(xb_ld(&bar[XB_TOPGEN]) == tg, bar);
            __builtin_amdgcn_fence(__ATOMIC_ACQUIRE, "agent");
            xb_add(&bar[XB_XGEN(b.x)], 1u);
            asm volatile("s_waitcnt vmcnt(0)" ::: "memory");
        } else {
            XB_SPIN(xb_ld(&bar[XB_XGEN(b.x)]) == gen, bar);
            __builtin_amdgcn_fence(__ATOMIC_ACQUIRE, "agent");
            asm volatile("s_waitcnt vmcnt(0)" ::: "memory");
        }
    }
    __syncthreads();
}

DI void gbar(LAS unsigned char* lds);
DI float rb16(float v) { return __uint_as_float(pk2(v, 0.f) << 16); }
template <int K> DI void skinny(LAS unsigned char* lds, const bf16_t* Bt, const int N, float* C) {
    constexpr int NIT = (K + 511) / 512;
    const int tid = otid(), lane = tid & 63, gw = blockIdx.x * 8 + (tid >> 6), nw = gridDim.x * 8;
    for (int n = gw; n < N; n += nw) {
        float acc[16];
#pragma unroll
        for (int r = 0; r < 16; ++r) acc[r] = 0.f;
        u32x4 bw[NIT];
#pragma unroll
        for (int it = 0; it < NIT; ++it) { const int k0 = lane * 8 + 512 * it; bw[it] = (u32x4){0u, 0u, 0u, 0u}; if (k0 < K) bw[it] = *(const u32x4*)(Bt + (size_t)n * K + k0); }
#pragma unroll
        for (int it = 0; it < NIT; ++it) { const int k0 = lane * 8 + 512 * it;
            if (k0 < K) { const float b0 = bflo(bw[it].x), b1 = bfhi(bw[it].x), b2 = bflo(bw[it].y), b3 = bfhi(bw[it].y), b4 = bflo(bw[it].z), b5 = bfhi(bw[it].z), b6 = bflo(bw[it].w), b7 = bfhi(bw[it].w);
#pragma unroll
                for (int r = 0; r < 16; ++r) { const u32x4 aw = *(const LAS u32x4*)(lds + LDS_MA + (r * K + k0) * 2);
                    acc[r] += (bflo(aw.x) * b0 + bfhi(aw.x) * b1) + (bflo(aw.y) * b2 + bfhi(aw.y) * b3) + (bflo(aw.z) * b4 + bfhi(aw.z) * b5) + (bflo(aw.w) * b6 + bfhi(aw.w) * b7); } } }
#pragma unroll
        for (int k = 0; k < 8; ++k) { const bool hi = lane & 1; const float snd = hi ? acc[k] : acc[k + 8], kp = hi ? acc[k + 8] : acc[k]; acc[k] = kp + __shfl_xor(snd, 1); }
#pragma unroll
        for (int k = 0; k < 4; ++k) { const bool hi = lane & 2; const float snd = hi ? acc[k] : acc[k + 4], kp = hi ? acc[k + 4] : acc[k]; acc[k] = kp + __shfl_xor(snd, 2); }
#pragma unroll
        for (int k = 0; k < 2; ++k) { const bool hi = lane & 4; const float snd = hi ? acc[k] : acc[k + 2], kp = hi ? acc[k + 2] : acc[k]; acc[k] = kp + __shfl_xor(snd, 4); }
        { const bool hi = lane & 8; const float snd = hi ? acc[0] : acc[1], kp = hi ? acc[1] : acc[0]; acc[0] = kp + __shfl_xor(snd, 8); }
        float t = acc[0]; t += __shfl_xor(t, 16); t += __shfl_xor(t, 32);
        if (lane < 16) C[(8 * (lane & 1) + 4 * ((lane >> 1) & 1) + 2 * ((lane >> 2) & 1) + ((lane >> 3) & 1)) * N + n] = t;
    }
}
DI void meta_hm(LAS unsigned char* lds, const float* hsrc, const float* C, float* hdst) {
    const int tid = otid(), lane = tid & 63, wave = tid >> 6;
    LAS bf16_t* As = (LAS bf16_t*)(lds + LDS_MA); LAS float* RS = (LAS float*)(lds + LDS_MRS);
#pragma unroll
    for (int u = 0; u < 2; ++u) { const int r = 2 * wave + u; float ss = 0.f;
#pragma unroll
        for (int c = 0; c < 4; ++c) { const int col = c * 256 + lane * 4; f32x4 v = *(const f32x4*)(hsrc + r * 1024 + col); if (C) v += *(const f32x4*)(C + r * 1024 + col);
            if (hdst) *(f32x4*)(hdst + r * 1024 + col) = v;
            ss += (v[0] * v[0] + v[1] * v[1]) + (v[2] * v[2] + v[3] * v[3]);
            u32x2 w; w.x = pk2(v[0], v[1]); w.y = pk2(v[2], v[3]); *(LAS u32x2*)(As + r * 1024 + col) = w; }
        ss = wsum(ss); if (lane == 0) RS[r] = rsqrtf(ss * (1.0f / 1024.0f) + RMS_EPS); }
    __syncthreads();
}
DI void meta_front(const Params& p, LAS unsigned char* lds) {
    const int tid = otid(), lane = tid & 63, wave = tid >> 6, gt = blockIdx.x * 512 + tid, ntot = gridDim.x * 512;
    unsigned char* ws = p.ws;
    float* Cg0 = (float*)(ws + OFF_CM); float* Cg1 = Cg0 + 98304; float* Pm = (float*)(ws + OFF_PM); float* S0g = (float*)(ws + OFF_S0); float* HMg = (float*)(ws + OFF_HMG);
    const float* cosr = (const float*)(ws + OFF_COSR); const float* sinr = (const float*)(ws + OFF_SINR);
    const bf16_t* W1 = (const bf16_t*)(ws + OFF_W1);
    LAS bf16_t* As = (LAS bf16_t*)(lds + LDS_MA); LAS bf16_t* Ob = (LAS bf16_t*)(lds + LDS_MO); LAS float* RS = (LAS float*)(lds + LDS_MRS); float* SCg = (float*)(ws + OFF_SCG);
    int cur = 0;
    meta_hm(lds, p.meta, nullptr, HMg);
    for (int l = 0; l < 2; ++l) {
        const int tid = otid(), lane = tid & 63, wave = tid >> 6, gt = blockIdx.x * 512 + tid;
        const bf16_t* wl = W1 + l * W1_LAYER;
        { float* Cg = Cg0; skinny<1024>(lds, wl, RIN, Cg); gbar(lds);
        for (int idx = gt; idx < 16 * RIN; idx += ntot) { const int r = idx / RIN, n = idx - r * RIN; const float rs = RS[r]; float v = Cg[idx] * rs;
            if (n < 2048) { const int i = n & 127, n1 = n & ~128; const float x1 = Cg[r * RIN + n1] * rs, x2 = Cg[r * RIN + n1 + 128] * rs, c = cosr[r * 128 + i], sn = sinr[r * 128 + i];
                v = (n & 128) ? x1 * sn + x2 * c : x1 * c - x2 * sn; }
            Pm[idx] = rb16(v); }
        gbar(lds); }
        for (int idx = gt; idx < 4 * 256 * 512; idx += ntot) { const int hd = idx >> 17, d = (idx >> 9) & 255, c = idx & 511; const float lg2 = log2f(1.0f - exp2f(-5.0f - (float)hd)); float a = 0.f;
#pragma unroll 4
            for (int j = 0; j < 16; ++j) a += Pm[j * RIN + 1024 + hd * 256 + d] * rb16(Pm[j * RIN + 2048 + hd * 512 + c] * ex2(lg2 * (float)(15 - j)));
            S0g[(size_t)l * 524288 + idx] = a; }
        for (int t = blockIdx.x * 8 + wave; t < 1024; t += gridDim.x * 8) { const int hd = t >> 8, i = (t >> 4) & 15, j = t & 15; const float lg2 = log2f(1.0f - exp2f(-5.0f - (float)hd));
            const f32x4 qv = *(const f32x4*)(Pm + i * RIN + hd * 256 + lane * 4), kv = *(const f32x4*)(Pm + j * RIN + 1024 + hd * 256 + lane * 4);
            const float a = wsum((qv[0] * kv[0] + qv[1] * kv[1]) + (qv[2] * kv[2] + qv[3] * kv[3]));
            if (lane == 0) SCg[t] = rb16(a * ex2(lg2 * fabsf((float)(i - j)))); }
        gbar(lds);
        { LAS bf16_t* Vs = (LAS bf16_t*)(lds + LDS_MA); LAS float* SCs = (LAS float*)(lds + LDS_MA + 65536);
          for (int t = tid; t < 1024; t += 512) SCs[t] = SCg[t];
#pragma unroll 4
          for (int q = tid; q < 16 * 512; q += 512) { const int i = q >> 9, c4 = (q & 511) * 4; const f32x4 v = *(const f32x4*)(Pm + i * RIN + 2048 + c4);
              u32x2 w; w.x = pk2(v[0], v[1]); w.y = pk2(v[2], v[3]); *(LAS u32x2*)(Vs + i * 2048 + c4) = w; }
          __syncthreads();
          for (int idx = tid; idx < 16 * 2048; idx += 512) { const int i = idx >> 11, c = idx & 2047, hd = c >> 9; float a = 0.f;
#pragma unroll
              for (int j = 0; j < 16; ++j) a += SCs[hd * 256 + i * 16 + j] * __uint_as_float((unsigned)Vs[j * 2048 + c] << 16);
              Ob[idx] = (bf16_t)(pk2(a, 0.f) & 0xffffu); }
          __syncthreads(); }
        for (int task = wave; task < 64; task += 8) { const int i = task >> 2, hd = task & 3; const LAS bf16_t* po = Ob + i * 2048 + hd * 512 + lane * 8; float o[8]; float sm = 0.f;
#pragma unroll
            for (int e = 0; e < 8; ++e) { o[e] = __uint_as_float((unsigned)po[e] << 16); sm += o[e]; }
            const float mu = wsum(sm) * (1.0f / 512.0f); float q = 0.f;
#pragma unroll
            for (int e = 0; e < 8; ++e) { o[e] -= mu; q += o[e] * o[e]; }
            const float rstd = rsqrtf(wsum(q) * (1.0f / 512.0f) + GN_EPS);
#pragma unroll
            for (int e = 0; e < 8; ++e) { const int c = hd * 512 + lane * 8 + e; const float g = Pm[i * RIN + 4096 + c];
                As[i * 2048 + c] = (bf16_t)(pk2(silu_f(g) * (o[e] * rstd * p.ret_gn_g[l * 2048 + c]), 0.f) & 0xffffu); } }
        __syncthreads();
        skinny<2048>(lds, wl + W1_WO, 1024, Cg1); gbar(lds);
        meta_hm(lds, HMg + cur * 16384, Cg1, HMg + (cur ^ 1) * 16384); cur ^= 1;
        skinny<1024>(lds, wl + W1_WUP, 5632, Cg0); gbar(lds);
#pragma unroll 2
        for (int q = tid; q < 16 * (FFH / 4); q += 512) { const int r = q / (FFH / 4), c = (q - r * (FFH / 4)) * 4, g = c >> 7, j = c & 127; const float rs = RS[r];
            const f32x4 a = *(const f32x4*)(Cg0 + r * 5632 + (2 * g) * 128 + j) * rs, b = *(const f32x4*)(Cg0 + r * 5632 + (2 * g + 1) * 128 + j) * rs;
            u32x2 w; w.x = pk2(silu_f(a[0]) * b[0], silu_f(a[1]) * b[1]); w.y = pk2(silu_f(a[2]) * b[2], silu_f(a[3]) * b[3]); *(LAS u32x2*)(As + r * FFH + c) = w; }
        __syncthreads();
        skinny<FFH>(lds, wl + W1_WDN, 1024, Cg1); gbar(lds);
        meta_hm(lds, HMg + cur * 16384, Cg1, HMg + (cur ^ 1) * 16384); cur ^= 1;
    }
}
DI void meta_kv(const Params& p, LAS unsigned char* lds) {
    const int tid = otid(), lane = tid & 63, wave = tid >> 6;
    unsigned char* ws = p.ws;
    float* Cg0 = (float*)(ws + OFF_CM); float* Cg1 = Cg0 + 98304; const float* HMg = (const float*)(ws + OFF_HMG);
    const float* cosm = (const float*)(ws + OFF_COSM); const float* sinm = (const float*)(ws + OFF_SINM);
    const bf16_t* W2 = (const bf16_t*)(ws + OFF_W2);
    bf16_t* KnM = (bf16_t*)(ws + OFF_KNM); bf16_t* VM = (bf16_t*)(ws + OFF_VM); bf16_t* KrM = (bf16_t*)(ws + OFF_KRM);
    LAS bf16_t* As = (LAS bf16_t*)(lds + LDS_MA); LAS float* RS = (LAS float*)(lds + LDS_MRS);
    meta_hm(lds, HMg, nullptr, nullptr);
    skinny<1024>(lds, W2, 768, Cg0); gbar(lds);
#pragma unroll
    for (int u = 0; u < 2; ++u) { const int r = 2 * wave + u; const float rs = RS[r]; float v[8]; float ss = 0.f;
#pragma unroll
        for (int e = 0; e < 8; ++e) { v[e] = Cg0[r * 768 + lane * 8 + e] * rs; ss += v[e] * v[e]; }
        ss = wsum(ss);
#pragma unroll
        for (int e = 0; e < 8; ++e) As[r * 512 + lane * 8 + e] = (bf16_t)(pk2(v[e], 0.f) & 0xffffu);
        if (lane == 0) RS[16 + r] = rsqrtf(ss * (1.0f / 512.0f) + RMS_EPS);
        if (lane < 32) { const float x1 = Cg0[r * 768 + 512 + lane] * rs, x2 = Cg0[r * 768 + 640 + lane] * rs, c = cosm[r * 32 + lane], sn = sinm[r * 32 + lane];
            KrM[(48 + r) * 64 + lane] = (bf16_t)(pk2(x1 * c - x2 * sn, 0.f) & 0xffffu); KrM[(48 + r) * 64 + 32 + lane] = (bf16_t)(pk2(x1 * sn + x2 * c, 0.f) & 0xffffu); } }
    for (int idx = tid; idx < 48 * 1024; idx += 512) { KnM[idx] = 0; VM[idx] = 0; }
    for (int idx = tid; idx < 48 * 64; idx += 512) KrM[idx] = 0;
    __syncthreads();
    skinny<512>(lds, W2 + W2_KVB, 2048, Cg1); gbar(lds);
    for (int idx = tid; idx < 16 * 2048; idx += 512) { const int r = idx >> 11, n = idx & 2047, head = n >> 8, j = n & 255; const float v = Cg1[idx] * RS[16 + r];
        bf16_t* dst = (j < 128 ? KnM : VM) + (48 + r) * 1024 + head * 128 + (j & 127); *dst = (bf16_t)(pk2(v, 0.f) & 0xffffu); }
    __syncthreads();
}

typedef const __attribute__((address_space(4))) Params* KArgP;
DI Params ldp() {
#if defined(__HIP_DEVICE_COMPILE__)
    KArgP kp = (KArgP)__builtin_amdgcn_kernarg_segment_ptr(); asm volatile("" : "+s"(kp));
    Params r; const __attribute__((address_space(4))) unsigned long long* s = (const __attribute__((address_space(4))) unsigned long long*)kp; unsigned long long* d = (unsigned long long*)&r;
#pragma unroll
    for (int i = 0; i < (int)(sizeof(Params) / 8); ++i) d[i] = s[i];
    return r;
#else
    return Params{};
#endif
}
#ifndef PHM
#define PHM 0xffff
#endif
#ifndef PHD
#define PHD 0
#endif
#define WSP(T, off) ((T*)(ws + (off)))
DI void zero_rs(float* rs) { int st = (int)gridDim.x * 512; asm volatile("" : "+s"(st)); float z = 0.f; asm volatile("" : "+v"(z)); for (int i = (int)blockIdx.x * 512 + otid(); i < MR; i += st) rs[i] = z; }
DI void ph_win(LAS unsigned char* lds, int l) { const Params p = ldp(); unsigned char* ws = p.ws; zero_rs(WSP(float, OFF_SSQ) + MR);
    EpiWin E{WSP(bf16_t, OFF_PROJ), WSP(float, OFF_SSQ), WSP(float, OFF_COSR), WSP(float, OFF_SINR)}; run_gemm(lds, WSP(bf16_t, OFF_HB), DM, WSP(bf16_t, OFF_W1) + l * W1_LAYER, RIN, 1024, E); }
DI void ph_res(LAS unsigned char* lds, const bf16_t* A, int lda, const bf16_t* Bt, int K, bool first, bool mixer) { const Params p = ldp(); unsigned char* ws = p.ws;
    if (mixer) zero_rs(WSP(float, OFF_SSQ));
    EpiRes E{first ? p.x : p.out, p.out, WSP(float, OFF_HM), WSP(bf16_t, OFF_HB), WSP(float, OFF_SSQ) + (mixer ? MR : 0)}; run_gemm(lds, A, lda, Bt, 1024, K, E); }
DI void ph_up(LAS unsigned char* lds, const bf16_t* Bt) { const Params p = ldp(); unsigned char* ws = p.ws;
    EpiUp E{WSP(bf16_t, OFF_U), WSP(float, OFF_SSQ) + MR}; run_gemm(lds, WSP(bf16_t, OFF_HB), DM, Bt, 5632, 1024, E); }
DI void ph_null(LAS unsigned char* lds, const bf16_t* A, int lda, const bf16_t* Bt, int N, int K) { const Params p = ldp(); unsigned char* ws = p.ws;
    EpiNull E{WSP(float, OFF_SSQ2)}; run_gemm(lds, A, lda, Bt, N, K, E); }
DI void ph_kva(LAS unsigned char* lds) { const Params p = ldp(); unsigned char* ws = p.ws;
    EpiKva E{WSP(bf16_t, OFF_CKV), WSP(bf16_t, OFF_KR), WSP(float, OFF_SSQ), WSP(float, OFF_SSQ2), WSP(float, OFF_COSM), WSP(float, OFF_SINM)}; run_gemm(lds, WSP(bf16_t, OFF_HB), DM, WSP(bf16_t, OFF_W2), 768, 1024, E); }
DI void ph_qa(LAS unsigned char* lds, int jj) { const Params p = ldp(); unsigned char* ws = p.ws; zero_rs(WSP(float, OFF_SSQ) + MR);
    EpiQa E{WSP(bf16_t, OFF_CQ), WSP(float, OFF_SSQ), WSP(float, OFF_SSQ3)}; run_gemm(lds, WSP(bf16_t, OFF_HB), DM, WSP(bf16_t, OFF_W2) + W2_L0 + jj * W2_LAYER, 768, 1024, E); }
DI void ph_kvb(LAS unsigned char* lds) { const Params p = ldp(); unsigned char* ws = p.ws;
    EpiKvb E{WSP(bf16_t, OFF_KN), WSP(bf16_t, OFF_V), WSP(float, OFF_SSQ2)}; run_gemm(lds, WSP(bf16_t, OFF_CKV), 512, WSP(bf16_t, OFF_W2) + W2_KVB, 2048, 512, E); }
DI void ph_qb(LAS unsigned char* lds, int jj) { const Params p = ldp(); unsigned char* ws = p.ws;
    EpiQb E{WSP(bf16_t, OFF_QN), WSP(bf16_t, OFF_QR), WSP(float, OFF_SSQ3), WSP(float, OFF_COSM), WSP(float, OFF_SINM)}; run_gemm(lds, WSP(bf16_t, OFF_CQ), 768, WSP(bf16_t, OFF_W2) + W2_L0 + jj * W2_LAYER + W2_WQB, 1536, 768, E); }
DI void ph_attn(LAS unsigned char* lds) { const Params p = ldp(); unsigned char* ws = p.ws;
    attn_phase(lds, WSP(bf16_t, OFF_QN), WSP(bf16_t, OFF_QR), WSP(bf16_t, OFF_KN), WSP(bf16_t, OFF_KR), WSP(bf16_t, OFF_V), WSP(bf16_t, OFF_AO), WSP(bf16_t, OFF_KNM), WSP(bf16_t, OFF_KRM), WSP(bf16_t, OFF_VM)); }

DI void gbar(LAS unsigned char* lds) { const Params p = ldp(); XcdBarrier b; b.bar = (unsigned*)(p.ws + OFF_BAR); b.x = xb_xcc_id(); b.st = (volatile LAS unsigned*)(lds + LDS_XB); xcd_barrier(b); }

__global__ void __launch_bounds__(512, 2) yoco_fwd(Params p_unused) {
    extern __shared__ __attribute__((aligned(16))) unsigned char shm[];
    LAS unsigned char* lds = (LAS unsigned char*)shm;
    cg::grid_group grid = cg::this_grid();
    if (threadIdx.x < 4) ((volatile LAS unsigned*)(lds + LDS_XB))[threadIdx.x] = 0u;
    __syncthreads();
    { const Params p = ldp(); (void)xcd_barrier_post((unsigned*)(p.ws + OFF_BAR), (volatile LAS unsigned*)(lds + LDS_XB)); }
    if (PHM & 1) { const Params p = ldp(); prologue_rows(p); }
    if (PHM & 2) { const Params p = ldp(); convert_set1(p, lds); }
    grid.sync();
    { const Params p = ldp(); meta_front(p, lds); }
    if (PHD & 131072) { const Params p = ldp(); meta_front(p, lds); }
    for (int l = 0; l < 2; ++l) {
        if (PHM & 4) ph_win(lds, l);
        if (PHD & 4) ph_win(lds, l);
        gbar(lds);
        if (PHM & 8) { const Params p = ldp(); ret_phase<false>(lds, (bf16_t*)(p.ws + OFF_PROJ), nullptr, (const float*)(p.ws + OFF_S0) + (size_t)l * 524288); }
        if (PHD & 8) { const Params p = ldp(); ret_phase<true>(lds, (bf16_t*)(p.ws + OFF_PROJ), (bf16_t*)(p.ws + OFF_HB), (const float*)(p.ws + OFF_S0) + (size_t)l * 524288); }
        gbar(lds);
        if (PHM & 16) { const Params p = ldp(); gn_phase(p, l, (bf16_t*)(p.ws + OFF_PROJ)); }
        gbar(lds);
        if (PHM & 32) { const Params p = ldp(); unsigned char* ws = p.ws; ph_res(lds, WSP(bf16_t, OFF_PROJ) + 4096, RIN, WSP(bf16_t, OFF_W1) + l * W1_LAYER + W1_WO, 2048, l == 0, true); }
        gbar(lds);
        if (PHM & 64) { const Params p = ldp(); unsigned char* ws = p.ws; ph_up(lds, WSP(bf16_t, OFF_W1) + l * W1_LAYER + W1_WUP); }
        if (PHD & 64) { const Params p = ldp(); unsigned char* ws = p.ws; ph_up(lds, WSP(bf16_t, OFF_W1) + l * W1_LAYER + W1_WUP); }
        if (PHD & 8192) { const Params p = ldp(); unsigned char* ws = p.ws; ph_null(lds, WSP(bf16_t, OFF_HB), DM, WSP(bf16_t, OFF_W1) + l * W1_LAYER + W1_WUP, 5632, 1024); }
        gbar(lds);
        if (PHD & 16384) { const Params p = ldp(); unsigned char* ws = p.ws; ph_null(lds, WSP(bf16_t, OFF_U), FFH, WSP(bf16_t, OFF_W1) + l * W1_LAYER + W1_WDN, 1024, FFH); }
        if (PHM & 32) { const Params p = ldp(); unsigned char* ws = p.ws; ph_res(lds, WSP(bf16_t, OFF_U), FFH, WSP(bf16_t, OFF_W1) + l * W1_LAYER + W1_WDN, FFH, false, false); }
        if ((PHM & 2) && l == 1) { const Params p = ldp(); const int nfive = 1056 - 4 * (int)gridDim.x; if (nfive <= 0 || nfive >= (int)gridDim.x) convert_set2(p, lds, (int)blockIdx.x, (int)gridDim.x); else if ((int)blockIdx.x >= nfive) convert_set2(p, lds, (int)blockIdx.x - nfive, (int)gridDim.x - nfive); }
        gbar(lds);
    }
    { const Params p = ldp(); meta_kv(p, lds); }
    for (int jj = 0; jj < 2; ++jj) {
        if ((PHM & 128) && jj == 0) ph_kva(lds);
        if (PHM & 256) ph_qa(lds, jj);
        gbar(lds);
        if ((PHM & 512) && jj == 0) ph_kvb(lds);
        if (PHM & 1024) ph_qb(lds, jj);
        gbar(lds);
        if (PHM & 2048) ph_attn(lds);
        if (PHD & 2048) ph_attn(lds);
        gbar(lds);
        if (PHM & 32) { const Params p = ldp(); unsigned char* ws = p.ws; ph_res(lds, WSP(bf16_t, OFF_AO), DM, WSP(bf16_t, OFF_W2) + W2_L0 + jj * W2_LAYER + W2_WOM, 1024, false, true); }
        gbar(lds);
        if (PHM & 64) { const Params p = ldp(); unsigned char* ws = p.ws; ph_up(lds, WSP(bf16_t, OFF_W2) + W2_L0 + jj * W2_LAYER + W2_WUP); }
        if (PHD & 64) { const Params p = ldp(); unsigned char* ws = p.ws; ph_up(lds, WSP(bf16_t, OFF_W2) + W2_L0 + jj * W2_LAYER + W2_WUP); }
        if (PHD & 8192) { const Params p = ldp(); unsigned char* ws = p.ws; ph_null(lds, WSP(bf16_t, OFF_HB), DM, WSP(bf16_t, OFF_W2) + W2_L0 + jj * W2_LAYER + W2_WUP, 5632, 1024); }
        gbar(lds);
        if (PHD & 16384) { const Params p = ldp(); unsigned char* ws = p.ws; ph_null(lds, WSP(bf16_t, OFF_U), FFH, WSP(bf16_t, OFF_W2) + W2_L0 + jj * W2_LAYER + W2_WDN, 1024, FFH); }
        if (PHM & 32) { const Params p = ldp(); unsigned char* ws = p.ws; ph_res(lds, WSP(bf16_t, OFF_U), FFH, WSP(bf16_t, OFF_W2) + W2_L0 + jj * W2_LAYER + W2_WDN, FFH, false, false); }
        gbar(lds);
    }
    if (PHD & 32768) { for (int k = 0; k < 40; ++k) gbar(lds); }
    if (PHM & 4096) { const Params p = ldp(); final_phase(p); }
}

extern "C" void kernel_launch(void* const* d_in, const int* in_sizes, int n_in, void* d_out, int out_size, void* d_ws, size_t ws_size, hipStream_t stream) {
    static int grid = 0;
    if (grid == 0) {
        if (n_in != 19 || out_size != NB * SEQ * DM || ws_size < WS_END2) { fprintf(stderr, "kernel_launch: unexpected shapes (n_in %d out %d ws %zu)\n", n_in, out_size, ws_size); grid = -1; return; }
        int dev = 0, cus = 0, per_cu = 0;
        (void)hipGetDevice(&dev); (void)hipDeviceGetAttribute(&cus, hipDeviceAttributeMultiprocessorCount, dev);
        (void)hipFuncSetAttribute((const void*)yoco_fwd, hipFuncAttributeMaxDynamicSharedMemorySize, LDS_BYTES);
        (void)hipOccupancyMaxActiveBlocksPerMultiprocessor(&per_cu, (const void*)yoco_fwd, 512, LDS_BYTES);
        if (per_cu < 1) per_cu = 1;
        grid = cus * per_cu;
    }
    if (grid < 0) return;
    (void)hipMemsetAsync((unsigned char*)d_ws + OFF_BAR, 0, XCD_BAR_WORDS * 4, stream);
    Params p{};
    const float** f = (const float**)&p;
    for (int i = 0; i < 19; ++i) f[i] = (const float*)d_in[i];
    p.out = (float*)d_out; p.ws = (unsigned char*)d_ws;
    void* args[] = {&p};
    hipError_t e = hipLaunchCooperativeKernel((const void*)yoco_fwd, dim3(grid), dim3(512), args, LDS_BYTES, stream);
    if (e != hipSuccess) fprintf(stderr, "cooperative launch failed: %s (grid %d)\n", hipGetErrorString(e), grid);
}
```
